# Optimizing an MI355X kernel written in HIP

```python
import jax
import jax.numpy as jnp
from jax import lax
import numpy as np

D_MODEL = 2048
BATCH = 2
SEQ = 4096
DEPTH = 2

GRID_W = 64
CTX_LEN = 256
EPS = 1e-6
ROPE_THETA = 10000.0
NEG_INF = -1e30
Q_BLOCK = 128

MLA_HEADS = 8
MLA_Q_RANK = 512
MLA_KV_RANK = 512
MLA_NOPE = 128
MLA_ROPE = 64
MLA_QK = MLA_NOPE + MLA_ROPE
MLA_V = 128
NA_HEADS = 4
NA_HD = 128
NA_ROWS = 8
NA_COLS = 16
NA_QC = 16
NA_KC = 2 * NA_QC
GQA_HEADS = 8
GQA_KV_HEADS = 2
GQA_HD = 64
GQA_WINDOW = 128
GQA_BLOCK = GQA_WINDOW
MOE_GROUPS = 4
MOE_PER_GROUP = 8
MOE_EXPERTS = MOE_GROUPS * MOE_PER_GROUP
MOE_TOPK = 2
MOE_HIDDEN = 512

IN_SIZES = (MLA_Q_RANK, MLA_KV_RANK, MLA_ROPE,
            NA_HEADS * NA_HD, NA_HEADS * NA_HD, NA_HEADS * NA_HD,
            GQA_HEADS * GQA_HD, GQA_KV_HEADS * GQA_HD, GQA_KV_HEADS * GQA_HD,
            D_MODEL, D_MODEL, D_MODEL)
IN_COLS = sum(IN_SIZES)
IN_SPLITS = tuple(int(s) for s in np.cumsum(IN_SIZES)[:-1])

kernel_name = 'hybrid_mla_natten_swa_hmoe_dit'


def rms_norm(x, g):
    xf = x.astype(jnp.float32)
    xf = xf * lax.rsqrt(jnp.mean(xf * xf, axis=-1, keepdims=True) + EPS)
    return (xf * g.astype(jnp.float32)).astype(x.dtype)


def modulate(h, shift, scale):
    return h * (1 + scale) + shift


def split_heads(t, n_heads):
    return t.reshape(t.shape[0], t.shape[1], n_heads, -1)


def axial_rope_tables(n_tokens, rot_dim):
    t = jnp.arange(n_tokens)
    row = (t // GRID_W).astype(jnp.float32)
    col = (t % GRID_W).astype(jnp.float32)
    n_freq = rot_dim // 4
    inv = ROPE_THETA ** (-jnp.arange(n_freq, dtype=jnp.float32) / n_freq)
    ang = jnp.concatenate([row[:, None] * inv, col[:, None] * inv], axis=-1)
    return jnp.cos(ang), jnp.sin(ang)


def apply_rope(x, cos, sin):
    half = x.shape[-1] // 2
    xf = x.astype(jnp.float32)
    x1, x2 = xf[..., :half], xf[..., half:]
    c, s = cos[:, None, :], sin[:, None, :]
    return jnp.concatenate([x1 * c - x2 * s, x1 * s + x2 * c], axis=-1).astype(x.dtype)


def attn_probs(s, sink=None):
    if sink is None:
        return jax.nn.softmax(s, axis=-1)
    s = jnp.concatenate([s, jnp.broadcast_to(sink, s.shape[:-1] + (1,))], axis=-1)
    return jax.nn.softmax(s, axis=-1)[..., :-1]


def context_attention(q, k, v, sink=None):
    B, C, Hq, dq = q.shape
    Hk = k.shape[2]
    G = Hq // Hk
    qg = q.reshape(B, C, Hk, G, dq)
    s = jnp.einsum('bqhgd,bshd->bhgqs', qg, k).astype(jnp.float32) * (dq ** -0.5)
    snk = None if sink is None else sink.astype(jnp.float32).reshape(Hk, G)[None, :, :, None, None]
    p = attn_probs(s, snk).astype(v.dtype)
    o = jnp.einsum('bhgqs,bshd->bqhgd', p, v)
    return o.reshape(B, C, Hq * v.shape[-1])


def mla_query(cq, p, rope):
    B, T, _ = cq.shape
    q = (rms_norm(cq, p['mla_q_norm_g']) @ p['mla_w_uq']).reshape(B, T, MLA_HEADS, MLA_QK)
    q = rms_norm(q, p['mla_qn_g'])
    if rope is not None:
        q = jnp.concatenate([q[..., :MLA_NOPE], apply_rope(q[..., MLA_NOPE:], *rope)], axis=-1)
    return q


def mla_key_value(ckv, krope, p, rope):
    B, T, _ = ckv.shape
    kv = (rms_norm(ckv, p['mla_kv_norm_g']) @ p['mla_w_ukv']).reshape(B, T, MLA_HEADS, MLA_NOPE + MLA_V)
    k_rope = jnp.broadcast_to(krope[:, :, None, :], (B, T, MLA_HEADS, MLA_ROPE))
    k = rms_norm(jnp.concatenate([kv[..., :MLA_NOPE], k_rope], axis=-1), p['mla_kn_g'])
    if rope is not None:
        k = jnp.concatenate([k[..., :MLA_NOPE], apply_rope(k[..., MLA_NOPE:], *rope)], axis=-1)
    return k, kv[..., MLA_NOPE:]


def mla_latent_attention(q, k_all, v_all):
    B, S, H, dq = q.shape
    nb = S // Q_BLOCK
    qb = q.reshape(B, nb, Q_BLOCK, H, dq).transpose(1, 0, 2, 3, 4)

    def one_block(q_blk):
        s = jnp.einsum('bqhd,bkhd->bhqk', q_blk, k_all).astype(jnp.float32) * (dq ** -0.5)
        pr = jax.nn.softmax(s, axis=-1).astype(v_all.dtype)
        return jnp.einsum('bhqk,bkhd->bqhd', pr, v_all)

    o = lax.map(one_block, qb)
    return o.transpose(1, 0, 2, 3, 4).reshape(B, S, H * v_all.shape[-1])


def neighbourhood_latent_attention(q, k, v, k_ctx, v_ctx, rpb):
    B, S, H, d = q.shape
    rows = S // GRID_W
    kr = min(NA_ROWS, rows)
    ncb = GRID_W // NA_QC
    r = jnp.arange(rows)
    key_rows = jnp.clip(r - kr // 2, 0, rows - kr)[:, None] + jnp.arange(kr)[None, :]
    qcol = jnp.arange(ncb)[:, None] * NA_QC + jnp.arange(NA_QC)[None, :]
    col_start = jnp.clip(qcol - NA_COLS // 2, 0, GRID_W - NA_COLS)
    blk_start = jnp.clip(jnp.arange(ncb) * NA_QC - NA_COLS // 2, 0, GRID_W - NA_KC)
    key_cols = blk_start[:, None] + jnp.arange(NA_KC)[None, :]
    kc = key_cols[:, None, :]
    in_win = (kc >= col_start[..., None]) & (kc < col_start[..., None] + NA_COLS)
    dr = key_rows - r[:, None] + NA_ROWS - 1
    dc = jnp.clip(kc - qcol[..., None], 1 - NA_COLS, NA_COLS - 1) + NA_COLS - 1
    bias = rpb[:, dr[:, None, None, :, None], dc[None, :, :, None, :]]

    def gather(t):
        grid = t.reshape(B, rows, GRID_W, H, d)
        return grid[:, key_rows[:, None, :, None], key_cols[None, :, None, :]]

    kg, vg = gather(k), gather(v)
    qg = q.reshape(B, rows, ncb, NA_QC, H, d)
    scale = d ** -0.5
    s_loc = jnp.einsum('brjqhd,brjakhd->bhrjqak', qg, kg).astype(jnp.float32) * scale + bias.astype(jnp.float32)
    s_loc = jnp.where(in_win[None, None, None, :, :, None, :], s_loc, NEG_INF)
    n_loc = kr * NA_KC
    s_loc = s_loc.reshape(B, H, rows, ncb, NA_QC, n_loc)
    s_ctx = jnp.einsum('brjqhd,bshd->bhrjqs', qg, k_ctx).astype(jnp.float32) * scale
    pr = jax.nn.softmax(jnp.concatenate([s_loc, s_ctx], axis=-1), axis=-1).astype(v.dtype)
    p_loc = pr[..., :n_loc].reshape(B, H, rows, ncb, NA_QC, kr, NA_KC)
    o = (jnp.einsum('bhrjqak,brjakhd->brjqhd', p_loc, vg)
         + jnp.einsum('bhrjqs,bshd->brjqhd', pr[..., n_loc:], v_ctx))
    return o.reshape(B, S, H * d)


def window_gqa_latent_attention(q, k, v, k_ctx, v_ctx, sink):
    B, S, Hq, d = q.shape
    Hk = k.shape[2]
    G = Hq // Hk
    W = GQA_BLOCK
    nb = S // W

    def band(t):
        tp = jnp.pad(t, ((0, 0), (W, W), (0, 0), (0, 0))).reshape(B, nb + 2, W, Hk, d)
        return jnp.concatenate([tp[:, :-2], tp[:, 1:-1], tp[:, 2:]], axis=2)

    kw, vw = band(k), band(v)
    qb = q.reshape(B, nb, W, Hk, G, d)
    scale = d ** -0.5
    s_loc = jnp.einsum('bnqhgd,bnkhd->bhgnqk', qb, kw).astype(jnp.float32) * scale
    qi = jnp.arange(W)[:, None]
    kj = jnp.arange(3 * W)[None, :]
    kpos = jnp.arange(nb)[:, None, None] * W - W + kj[None]
    valid = (jnp.abs(kj - W - qi) <= GQA_WINDOW)[None] & (kpos >= 0) & (kpos < S)
    s_loc = jnp.where(valid, s_loc, NEG_INF)
    s_ctx = jnp.einsum('bnqhgd,bshd->bhgnqs', qb, k_ctx).astype(jnp.float32) * scale
    snk = sink.astype(jnp.float32).reshape(Hk, G)[None, :, :, None, None, None]
    pr = attn_probs(jnp.concatenate([s_loc, s_ctx], axis=-1), snk).astype(v.dtype)
    n_loc = 3 * W
    o = (jnp.einsum('bhgnqk,bnkhd->bnqhgd', pr[..., :n_loc], vw)
         + jnp.einsum('bhgnqs,bshd->bnqhgd', pr[..., n_loc:], v_ctx))
    return o.reshape(B, S, Hq * d)


def merge_branches(o_a, o_b, o_c, gate_a, gate_b, gate_c, p):
    y = (jax.nn.sigmoid(gate_a) * (o_a @ p['w_o_mla'])
         + jax.nn.sigmoid(gate_b) * (o_b @ p['w_o_na'])
         + jax.nn.sigmoid(gate_c) * (o_c @ p['w_o_gqa']))
    return y @ p['w_out']


def token_mixer(h_lat, h_ctx, p, ctx_out):
    B, S, _ = h_lat.shape
    (cq, ckv, krope, na_q, na_k, na_v, g_q, g_k, g_v,
     gate_a, gate_b, gate_c) = jnp.split(h_lat @ p['w_in'], IN_SPLITS, axis=-1)
    (cq_c, ckv_c, krope_c, na_q_c, na_k_c, na_v_c, g_q_c, g_k_c, g_v_c,
     gate_a_c, gate_b_c, gate_c_c) = jnp.split(h_ctx @ p['w_in'], IN_SPLITS, axis=-1)
    rope_mla = axial_rope_tables(S, MLA_ROPE)
    rope_gqa = axial_rope_tables(S, GQA_HD)

    ka_l, va_l = mla_key_value(ckv, krope, p, rope_mla)
    ka_c, va_c = mla_key_value(ckv_c, krope_c, p, None)
    qa_l = mla_query(cq, p, rope_mla)
    oa_l = mla_latent_attention(qa_l, jnp.concatenate([ka_l, ka_c], axis=1),
                                jnp.concatenate([va_l, va_c], axis=1))

    kb_l = rms_norm(split_heads(na_k, NA_HEADS), p['na_kn_g'])
    vb_l = split_heads(na_v, NA_HEADS)
    kb_c = rms_norm(split_heads(na_k_c, NA_HEADS), p['na_kn_g'])
    vb_c = split_heads(na_v_c, NA_HEADS)
    qb_l = rms_norm(split_heads(na_q, NA_HEADS), p['na_qn_g'])
    ob_l = neighbourhood_latent_attention(qb_l, kb_l, vb_l, kb_c, vb_c, p['na_rpb'])

    kc_l = apply_rope(rms_norm(split_heads(g_k, GQA_KV_HEADS), p['gqa_kn_g']), *rope_gqa)
    vc_l = split_heads(g_v, GQA_KV_HEADS)
    kc_c = rms_norm(split_heads(g_k_c, GQA_KV_HEADS), p['gqa_kn_g'])
    vc_c = split_heads(g_v_c, GQA_KV_HEADS)
    qc_l = apply_rope(rms_norm(split_heads(g_q, GQA_HEADS), p['gqa_qn_g']), *rope_gqa)
    oc_l = window_gqa_latent_attention(qc_l, kc_l, vc_l, kc_c, vc_c, p['gqa_sink'])

    y_lat = merge_branches(oa_l, ob_l, oc_l, gate_a, gate_b, gate_c, p)
    if not ctx_out:
        return y_lat, None
    oa_c = context_attention(mla_query(cq_c, p, None), ka_c, va_c)
    ob_c = context_attention(rms_norm(split_heads(na_q_c, NA_HEADS), p['na_qn_g']), kb_c, vb_c)
    oc_c = context_attention(rms_norm(split_heads(g_q_c, GQA_HEADS), p['gqa_qn_g']), kc_c, vc_c, p['gqa_sink'])
    y_ctx = merge_branches(oa_c, ob_c, oc_c, gate_a_c, gate_b_c, gate_c_c, p)
    return y_lat, y_ctx


def hier_moe(h, p):
    B, T, _ = h.shape
    gp = jax.nn.softmax((h @ p['moe_w_group'] + p['moe_b_group']).astype(jnp.float32), axis=-1)
    g_w, g_idx = lax.top_k(gp, 1)
    g_onehot = jax.nn.one_hot(g_idx[..., 0], MOE_GROUPS, dtype=jnp.float32)
    el = (h @ p['moe_w_expert'] + p['moe_b_expert']).astype(jnp.float32)
    el = el.reshape(B, T, MOE_GROUPS, MOE_PER_GROUP)
    el_g = jnp.einsum('btge,btg->bte', el, g_onehot)
    top_l, top_i = lax.top_k(el_g, MOE_TOPK)
    w_sel = jax.nn.softmax(top_l, axis=-1) * g_w
    expert_id = g_idx * MOE_PER_GROUP + top_i
    combine = jnp.einsum('btk,btke->bte', w_sel, jax.nn.one_hot(expert_id, MOE_EXPERTS, dtype=jnp.float32))
    hg = jnp.einsum('btd,edf->btef', h, p['moe_w_gate'])
    hu = jnp.einsum('btd,edf->btef', h, p['moe_w_up'])
    act = jax.nn.silu(hg) * hu * combine[..., None].astype(h.dtype)
    return jnp.einsum('btef,efd->btd', act, p['moe_w_down'])


def setup_inputs(seed: int = 0) -> dict:
    key = jax.random.key(seed)
    ks = iter(jax.random.split(key, 40))
    L, D = DEPTH, D_MODEL

    def nrm(shape, scale):
        return jax.random.normal(next(ks), shape, jnp.float32) * scale

    def gain(shape):
        return 1.0 + nrm(shape, 0.02)

    return {
        'x': nrm((BATCH, SEQ, D), 1.0),
        'c': nrm((BATCH, D), 1.0),
        'ctx': nrm((BATCH, CTX_LEN, D), 1.0),
        'c_ctx': nrm((D,), 1.0),
        'ada_w': nrm((L, D, 6 * D), 0.5 * D ** -0.5),
        'ada_b': nrm((L, 6 * D), 0.02),
        'norm_mix_g': gain((L, D)),
        'norm_ffn_g': gain((L, D)),
        'w_in': nrm((L, D, IN_COLS), D ** -0.5),
        'mla_q_norm_g': gain((L, MLA_Q_RANK)),
        'mla_w_uq': nrm((L, MLA_Q_RANK, MLA_HEADS * MLA_QK), MLA_Q_RANK ** -0.5),
        'mla_kv_norm_g': gain((L, MLA_KV_RANK)),
        'mla_w_ukv': nrm((L, MLA_KV_RANK, MLA_HEADS * (MLA_NOPE + MLA_V)), MLA_KV_RANK ** -0.5),
        'mla_qn_g': gain((L, MLA_QK)),
        'mla_kn_g': gain((L, MLA_QK)),
        'na_qn_g': gain((L, NA_HD)),
        'na_kn_g': gain((L, NA_HD)),
        'na_rpb': nrm((L, NA_HEADS, 2 * NA_ROWS - 1, 2 * NA_COLS - 1), 0.1),
        'gqa_qn_g': gain((L, GQA_HD)),
        'gqa_kn_g': gain((L, GQA_HD)),
        'gqa_sink': nrm((L, GQA_HEADS), 0.5),
        'w_o_mla': nrm((L, MLA_HEADS * MLA_V, D), (MLA_HEADS * MLA_V) ** -0.5),
        'w_o_na': nrm((L, NA_HEADS * NA_HD, D), (NA_HEADS * NA_HD) ** -0.5),
        'w_o_gqa': nrm((L, GQA_HEADS * GQA_HD, D), (GQA_HEADS * GQA_HD) ** -0.5),
        'w_out': nrm((L, D, D), D ** -0.5),
        'moe_w_group': nrm((L, D, MOE_GROUPS), D ** -0.5),
        'moe_b_group': nrm((L, MOE_GROUPS), 0.01),
        'moe_w_expert': nrm((L, D, MOE_EXPERTS), D ** -0.5),
        'moe_b_expert': nrm((L, MOE_EXPERTS), 0.01),
        'moe_w_gate': nrm((L, MOE_EXPERTS, D, MOE_HIDDEN), D ** -0.5),
        'moe_w_up': nrm((L, MOE_EXPERTS, D, MOE_HIDDEN), D ** -0.5),
        'moe_w_down': nrm((L, MOE_EXPERTS, MOE_HIDDEN, D), MOE_HIDDEN ** -0.5),
    }


def reference(x, c, ctx, c_ctx, ada_w, ada_b, norm_mix_g, norm_ffn_g, w_in,
              mla_q_norm_g, mla_w_uq, mla_kv_norm_g, mla_w_ukv, mla_qn_g, mla_kn_g,
              na_qn_g, na_kn_g, na_rpb, gqa_qn_g, gqa_kn_g, gqa_sink,
              w_o_mla, w_o_na, w_o_gqa, w_out,
              moe_w_group, moe_b_group, moe_w_expert, moe_b_expert,
              moe_w_gate, moe_w_up, moe_w_down):
    x_lat, x_ctx = x, ctx
    for l in range(DEPTH):
        ctx_out = l < DEPTH - 1
        p = {
            'w_in': w_in[l], 'mla_q_norm_g': mla_q_norm_g[l], 'mla_w_uq': mla_w_uq[l],
            'mla_kv_norm_g': mla_kv_norm_g[l], 'mla_w_ukv': mla_w_ukv[l],
            'mla_qn_g': mla_qn_g[l], 'mla_kn_g': mla_kn_g[l],
            'na_qn_g': na_qn_g[l], 'na_kn_g': na_kn_g[l], 'na_rpb': na_rpb[l],
            'gqa_qn_g': gqa_qn_g[l], 'gqa_kn_g': gqa_kn_g[l], 'gqa_sink': gqa_sink[l],
            'w_o_mla': w_o_mla[l], 'w_o_na': w_o_na[l], 'w_o_gqa': w_o_gqa[l], 'w_out': w_out[l],
            'moe_w_group': moe_w_group[l], 'moe_b_group': moe_b_group[l],
            'moe_w_expert': moe_w_expert[l], 'moe_b_expert': moe_b_expert[l],
            'moe_w_gate': moe_w_gate[l], 'moe_w_up': moe_w_up[l], 'moe_w_down': moe_w_down[l],
        }
        mod_l = jax.nn.silu(c) @ ada_w[l] + ada_b[l]
        mod_c = jax.nn.silu(c_ctx) @ ada_w[l] + ada_b[l]
        sh1, sc1, g1, sh2, sc2, g2 = jnp.split(mod_l[:, None, :], 6, axis=-1)
        csh1, csc1, cg1, csh2, csc2, cg2 = jnp.split(mod_c, 6, axis=-1)

        h_lat = modulate(rms_norm(x_lat, norm_mix_g[l]), sh1, sc1)
        h_ctx = modulate(rms_norm(x_ctx, norm_mix_g[l]), csh1, csc1)
        y_lat, y_ctx = token_mixer(h_lat, h_ctx, p, ctx_out)
        x_lat = x_lat + g1 * y_lat
        h = modulate(rms_norm(x_lat, norm_ffn_g[l]), sh2, sc2)
        x_lat = x_lat + g2 * hier_moe(h, p)
        if ctx_out:
            x_ctx = x_ctx + cg1 * y_ctx
            hc = modulate(rms_norm(x_ctx, norm_ffn_g[l]), csh2, csc2)
            x_ctx = x_ctx + cg2 * hier_moe(hc, p)
    return x_lat
```

```cpp
#include <hip/hip_runtime.h>
#include <stdint.h>
#include <stdio.h>

#ifndef REPMASK
#define REPMASK 0
#endif
#define REPS(k) (1 + ((REPMASK >> (k)) & 1))
#ifndef MK_ONE_LAUNCH
#define MK_ONE_LAUNCH 1
#endif

#define LAS __attribute__((address_space(3)))
#define GAS __attribute__((address_space(1)))
typedef unsigned short bf16_t;
typedef short bf16x8 __attribute__((ext_vector_type(8)));
typedef short s16x4 __attribute__((ext_vector_type(4)));
typedef float f32x4 __attribute__((ext_vector_type(4)));
typedef float f32x16 __attribute__((ext_vector_type(16)));
typedef unsigned u32x4 __attribute__((ext_vector_type(4)));
typedef unsigned u32x2 __attribute__((ext_vector_type(2)));

constexpr int DM = 2048, NB = 2, SEQ = 4096, TL = NB * SEQ, CL = 256, TC = NB * CL, TT = TL + TC, NLAYER = 2;
constexpr float EPS = 1e-6f;
constexpr float LOG2E = 1.4426950408889634f;
constexpr float THRL2 = 8.0f * LOG2E;
constexpr int IN_COLS = 9536;
constexpr int P_CQ = 0, P_CKV = 512, P_NAQ = 1024, P_NAK = 1536, P_NAV = 2048, P_GQ = 2560, P_GK = 3072, P_GV = 3200,
              P_GA = 3328, P_GB = 5376, P_GC = 7424, P_KR = 9472, PROJ_LD = 9728;
constexpr int NEXP = 32, MOE_H = 512;
constexpr int XS_ROWS = 25600;

constexpr size_t al256(size_t x) { return (x + 255) / 256 * 256; }
constexpr size_t WS_CTL = 0;
constexpr size_t CTL_BYTES = 65536;
constexpr size_t WS_MOD = WS_CTL + CTL_BYTES;
constexpr size_t WS_ROPE = WS_MOD + al256((size_t)NLAYER * 3 * 6 * DM * 4);
constexpr size_t WS_WIN = WS_ROPE + (size_t)SEQ * 32 * 8;
constexpr size_t SZ_WIN = (size_t)PROJ_LD * DM * 2;
constexpr size_t WS_WUP = WS_WIN + NLAYER * SZ_WIN;
constexpr size_t SZ_WUP = (size_t)3584 * 512 * 2;
constexpr size_t WS_WOC = WS_WUP + NLAYER * SZ_WUP;
constexpr size_t SZ_WOC = (size_t)2048 * 2048 * 2;
constexpr size_t WS_WOUT = WS_WOC + NLAYER * SZ_WOC;
constexpr size_t SZ_WOUT = (size_t)2048 * 2048 * 2;
constexpr size_t WS_WGU = WS_WOUT + NLAYER * SZ_WOUT;
constexpr size_t SZ_WGU = (size_t)NEXP * 1024 * 2048 * 2;
constexpr size_t WS_WD = WS_WGU + NLAYER * SZ_WGU;
constexpr size_t SZ_WD = (size_t)NEXP * 2048 * 512 * 2;
constexpr size_t WS_WR = WS_WD + NLAYER * SZ_WD;
constexpr size_t SZ_WR = (size_t)48 * 2048 * 2;
constexpr size_t WS_HBUF = WS_WR + NLAYER * SZ_WR;
constexpr size_t WS_OCAT = WS_HBUF + (size_t)TT * DM * 2;
constexpr size_t WS_YBUF = WS_OCAT + (size_t)TT * DM * 2;
constexpr size_t WS_Y = WS_YBUF + (size_t)TT * DM * 4;
constexpr size_t WS_XMID = WS_Y + (size_t)TT * DM * 2;
constexpr size_t WS_XL1 = WS_XMID + (size_t)TT * DM * 4;
constexpr size_t WS_TOK = WS_XL1 + (size_t)TT * DM * 4;
constexpr size_t SZ_TOK1 = al256((size_t)TT * 2 * 4);
constexpr size_t WS_SSQ = WS_TOK + 4 * SZ_TOK1;
constexpr size_t WS_HB8 = WS_SSQ + al256((size_t)NLAYER * TT * 16 * 4);
constexpr size_t WS_WIN8 = WS_HB8 + al256((size_t)TT * DM);
constexpr size_t SZ_WIN8 = (size_t)P_KR * DM;
constexpr size_t WS_WOUT8 = WS_WIN8 + NLAYER * SZ_WIN8;
constexpr size_t SZ_WOUT8 = (size_t)DM * DM;
constexpr size_t WS_Y8 = WS_WOUT8 + NLAYER * SZ_WOUT8;
constexpr size_t WS_WOC8 = WS_Y8 + (size_t)TL * DM;
constexpr size_t SZ_WOC8 = (size_t)DM * DM;
constexpr size_t WS_VT8 = WS_WOC8 + NLAYER * SZ_WOC8;
constexpr size_t WS_GT8 = WS_VT8 + (size_t)(TT / 64) * 8 * 8192;
constexpr size_t WS_CQ8 = WS_GT8 + (size_t)32 * 24 * 65536;
constexpr size_t WS_RLIST = WS_CQ8 + (size_t)TT * 1024;
constexpr size_t WS_R1 = WS_RLIST + al256((size_t)NEXP * TT * 4);
constexpr size_t WS_PROJ = WS_R1;
constexpr size_t WS_QRAW = WS_PROJ + (size_t)TT * PROJ_LD * 2;
constexpr size_t WS_KVRAW = WS_QRAW + (size_t)TT * 1536 * 2;
constexpr size_t WS_KM = WS_KVRAW + (size_t)TT * 2048 * 2;
constexpr size_t WS_R1_END = WS_KM + (size_t)TT * 1536 * 2;
constexpr size_t WS_XS = WS_R1;
constexpr size_t WS_H = WS_XS + (size_t)XS_ROWS * 2048 * 2;
constexpr size_t WS_Y2S = WS_H + (size_t)XS_ROWS * 512 * 2;
constexpr size_t WS_MOE_END = WS_Y2S + (size_t)XS_ROWS * 2048 * 2;
static_assert(WS_MOE_END <= WS_R1_END, "MoE buffers must fit the aliased region");
constexpr size_t WS_END = WS_R1_END;
static_assert(WS_END < 1280000000ull, "workspace budget");

constexpr int CW_BAR = 0;
constexpr int CW_CNT = 4096;
constexpr int CW_TILE = 4096 + 256;
constexpr int CW_DONE = 4096 + 128;

constexpr int LDS_STAGE = 131072;
constexpr int MISC_OFF = LDS_STAGE;
constexpr int LDS_BYTES = LDS_STAGE + 4096;

__device__ __forceinline__ unsigned cvt_pk_bf16(float lo, float hi) { unsigned r; asm volatile("v_cvt_pk_bf16_f32 %0, %1, %2" : "=v"(r) : "v"(lo), "v"(hi)); return r; }
__device__ __forceinline__ unsigned pk4_fp8(float a, float b, float c, float d) {
    a = fminf(fmaxf(a, -448.f), 448.f); b = fminf(fmaxf(b, -448.f), 448.f); c = fminf(fmaxf(c, -448.f), 448.f); d = fminf(fmaxf(d, -448.f), 448.f);
    int w = __builtin_amdgcn_cvt_pk_fp8_f32(a, b, 0, false); w = __builtin_amdgcn_cvt_pk_fp8_f32(c, d, w, true); return (unsigned)w;
}
__device__ __forceinline__ unsigned pk4_fp8_nc(float a, float b, float c, float d) { int w = __builtin_amdgcn_cvt_pk_fp8_f32(a, b, 0, false); w = __builtin_amdgcn_cvt_pk_fp8_f32(c, d, w, true); return (unsigned)w; }
__device__ __forceinline__ float bf_lo(unsigned w) { return __uint_as_float(w << 16); }
__device__ __forceinline__ float bf_hi(unsigned w) { return __uint_as_float(w & 0xffff0000u); }
__device__ __forceinline__ int lane_id() { return (int)__builtin_amdgcn_mbcnt_hi(~0u, __builtin_amdgcn_mbcnt_lo(~0u, 0u)); }
__device__ __forceinline__ float wave_sum(float v) {
#pragma unroll
    for (int o = 32; o > 0; o >>= 1) v += __shfl_xor(v, o);
    return v;
}
__device__ __forceinline__ void unpack8(const u32x4 w, float (&f)[8]);
__device__ __forceinline__ u32x4 pack8(const float (&f)[8]);
__device__ __forceinline__ float sigmoidf_(float x) { return __builtin_amdgcn_rcpf(1.0f + __expf(-x)); }
__device__ __forceinline__ float siluf_(float x) { return x * __builtin_amdgcn_rcpf(1.0f + __expf(-x)); }

#define XB_TMO      128
#define XB_XCNT(j)  (256  + 64 * (j))
#define XB_XSUB(j)  (1280 + 64 * (j))
#define XB_XGEN(j)  (2304 + 64 * (j))
#define XB_TOP      3328
#define XB_TOPGEN   3392
#define XCD_BAR_WORDS 3456
#define XB_SPIN_CAP (1u << 18)
__device__ __forceinline__ unsigned xb_ld(unsigned* p)              { return __hip_atomic_load(p, __ATOMIC_RELAXED, __HIP_MEMORY_SCOPE_AGENT); }
__device__ __forceinline__ unsigned xb_add(unsigned* p, unsigned v) { return __hip_atomic_fetch_add(p, v, __ATOMIC_RELAXED, __HIP_MEMORY_SCOPE_AGENT); }
__device__ __forceinline__ unsigned xb_xcc_id() { return (unsigned)__builtin_amdgcn_s_getreg((3 << 11) | 20) & 0xFu; }
#define XB_SPIN(cond, bar) do { unsigned _sp = 0; while (cond) { __builtin_amdgcn_s_sleep(1); \
    if ((++_sp & 255u) == 0u) { if (xb_ld(&(bar)[XB_TMO])) break; if (_sp > XB_SPIN_CAP) { atomicAdd(&(bar)[XB_TMO], 1u); break; } } } } while (0)
struct XcdBarrier { unsigned* bar; unsigned x; volatile LAS unsigned* st; int wave; };
__device__ __forceinline__ XcdBarrier xcd_barrier_post(unsigned* bar, volatile LAS unsigned* st, int wave) {
    XcdBarrier b; b.bar = bar; b.x = xb_xcc_id(); b.st = st; b.wave = wave;
    if (wave == 0 && lane_id() == 0) (void)xb_add(&bar[XB_XCNT(b.x)], 1u);
    return b;
}
__device__ __forceinline__ void xcd_barrier_complete(unsigned* bar, unsigned x, unsigned& nloc, unsigned& nx) {
    const unsigned G = gridDim.x * gridDim.y * gridDim.z;
    unsigned sum, cnt, mine, sp = 0u;
    for (;;) {
        sum = 0u; cnt = 0u; mine = 0u;
#pragma unroll
        for (unsigned j = 0; j < 16; ++j) { const unsigned c = xb_ld(&bar[XB_XCNT(j)]); sum += c; cnt += (c > 0u) ? 1u : 0u; mine = (j == x) ? c : mine; }
        if (sum == G) break;
        __builtin_amdgcn_s_sleep(1);
        if ((++sp & 255u) == 0u) { if (xb_ld(&bar[XB_TMO])) break; if (sp > XB_SPIN_CAP) { atomicAdd(&bar[XB_TMO], 1u); break; } }
    }
    nloc = mine > 0u ? mine : 1u; nx = cnt > 0u ? cnt : 1u;
}
__device__ __forceinline__ void xcd_barrier(const XcdBarrier& b) {
    asm volatile("s_waitcnt vmcnt(0)" ::: "memory");
    __syncthreads();
    if (b.wave == 0 && lane_id() == 0) {
        unsigned* bar = b.bar;
        __builtin_amdgcn_s_waitcnt(0);
        unsigned nloc = b.st[0], nx = b.st[1];
        if (nloc == 0u) { xcd_barrier_complete(bar, b.x, nloc, nx); b.st[0] = nloc; b.st[1] = nx; }
        const unsigned old = xb_add(&bar[XB_XSUB(b.x)], 1u);
        const unsigned gen = old / nloc;
        if (old + 1u == (gen + 1u) * nloc) {
            __builtin_amdgcn_fence(__ATOMIC_RELEASE, "agent");
            asm volatile("s_waitcnt vmcnt(0)" ::: "memory");
            const unsigned og = xb_add(&bar[XB_TOP], 1u);
            const unsigned tg = og / nx;
            if (og + 1u == (tg + 1u) * nx) xb_add(&bar[XB_TOPGEN], 1u);
            else XB_SPIN(xb_ld(&bar[XB_TOPGEN]) == tg, bar);
            __builtin_amdgcn_fence(__ATOMIC_ACQUIRE, "agent");
            xb_add(&bar[XB_XGEN(b.x)], 1u);
            asm volatile("s_waitcnt vmcnt(0)" ::: "memory");
        } else {
            XB_SPIN(xb_ld(&bar[XB_XGEN(b.x)]) == gen, bar);
            __builtin_amdgcn_fence(__ATOMIC_ACQUIRE, "agent");
            asm volatile("s_waitcnt vmcnt(0)" ::: "memory");
        }
    }
    __syncthreads();
}

struct Params { const float* in[32]; float* out; unsigned char* ws; int ph_lo, ph_hi; };
enum { I_X = 0, I_C, I_CTX, I_CCTX, I_ADAW, I_ADAB, I_NMIXG, I_NFFNG, I_WIN, I_MQNG, I_WUQ, I_MKVNG, I_WUKV, I_MQN, I_MKN,
       I_NAQN, I_NAKN, I_RPB, I_GQN, I_GKN, I_SINK, I_WOM, I_WON, I_WOG, I_WOUT, I_WGRP, I_BGRP, I_WEXP, I_BEXP, I_WG, I_WU, I_WDN };

struct Frame {
    unsigned char* ws; LAS unsigned char* lds; char* ldsg;
    int tid, lane, wave, G, bid, gw, nwt;
};

constexpr int PTAB_OFF = LDS_STAGE + 1024;
__device__ __forceinline__ const float* inp(const Frame& F, int i) {
    const LAS unsigned* t = (const LAS unsigned*)(F.lds + PTAB_OFF) + 2 * i;
    const unsigned lo = __builtin_amdgcn_readfirstlane(t[0]), hi = __builtin_amdgcn_readfirstlane(t[1]);
    return (const float*)(const GAS float*)(((unsigned long long)hi << 32) | lo);
}

__device__ __forceinline__ Frame refresh(const Frame& F0) {
    Frame F = F0; int t = F0.wave * 64 + lane_id(); asm volatile("" : "+v"(t));
    unsigned long long w = (unsigned long long)F.ws; int g = F.G, b = F.bid; asm volatile("" : "+s"(w), "+s"(g), "+s"(b));
    F.ws = (unsigned char*)(GAS unsigned char*)w; F.G = g; F.bid = b; F.nwt = g * 8;
    F.tid = t; F.lane = t & 63; F.wave = __builtin_amdgcn_readfirstlane(t >> 6); F.gw = F.bid * 8 + F.wave; return F;
}

namespace pg8 {
constexpr int BM = 256, BK = 64, HALF = 128, HTB = HALF * BK * 2, NXCD = 8, WGM = 8;
__device__ __forceinline__ int lds_byte(int r, int c) { const int st = (r >> 4) * 2 + (c >> 5), rr = r & 15, cc = c & 31, ob = rr * 64 + cc * 2; return st * 1024 + (ob ^ (((ob >> 9) & 1) << 5)); }
__device__ __forceinline__ void stage_rc(int b, int& R, int& C) { const int st = b / 1024, sb = b % 1024, swz = sb ^ (((sb >> 9) & 1) << 5); R = (st >> 1) * 16 + swz / 64; C = (st & 1) * 32 + (swz % 64) / 2; }
__device__ __forceinline__ int perm32(int rho) { const int n = rho >> 4, i = rho & 15; return 8 * (i >> 2) + 4 * n + (i & 3); }

struct Unit { unsigned aoff, boff; int pm, pn; int ge, glt, gcnt; };

struct SchedGrid {
    static constexpr bool GATHER = false;
    int nM, nN, nwg, G, c; unsigned lda2, ldb2; int split_pn; unsigned aextra_lo, aextra_hi;
    __device__ void init(int M, int N, int G_, int c_, int lda, int ldb) { nM = M / BM; nN = N / BM; nwg = nM * nN; G = G_; c = c_; lda2 = (unsigned)lda * 2u; ldb2 = (unsigned)ldb * 2u; split_pn = 1 << 30; aextra_lo = 0; aextra_hi = 0; }
    __device__ bool next(int i, Unit& u) const {
        const long L = (long)i * G + c; if (L >= nwg) return false;
        int wgid = (int)L; { const int q = nwg / NXCD, r = nwg % NXCD, xcd = wgid % NXCD, off = wgid / NXCD; wgid = (xcd < r ? xcd * (q + 1) : r * (q + 1) + (xcd - r) * q) + off; }
        const int nig = WGM * nN, gid = wgid / nig, fm = gid * WGM, gsz = (nM - fm) < WGM ? (nM - fm) : WGM;
        u.pm = fm + ((wgid % nig) % gsz); u.pn = (wgid % nig) / gsz;
        u.aoff = (unsigned)u.pm * BM * lda2 + (u.pn < split_pn ? aextra_lo : aextra_hi);
        u.boff = (unsigned)u.pn * BM * ldb2; u.ge = 0; u.glt = 0; u.gcnt = 0;
        return true;
    }
};
template <bool GATHER_>
struct SchedMoe {
    static constexpr bool GATHER = GATHER_;
    const int* tile_e; int ntile, nnl_shift, G, c; unsigned lda2, ldb2;
    const int* rlist; const unsigned* cnt;
    __device__ bool next(int i, Unit& u) const {
        const long L = (long)i * G + c; if (L >= ((long)ntile << nnl_shift)) return false;
        const int pm = (int)(L >> nnl_shift), pnl = (int)(L & ((1 << nnl_shift) - 1));
        const int e = __builtin_amdgcn_readfirstlane(tile_e[pm]);
        u.pm = pm; u.pn = pnl; u.aoff = GATHER_ ? 0u : (unsigned)pm * BM * lda2; u.boff = (unsigned)((e << nnl_shift) + pnl) * BM * ldb2;
        if (GATHER_) { u.ge = e; u.glt = __builtin_amdgcn_readfirstlane(tile_e[160 + pm]); u.gcnt = (int)__builtin_amdgcn_readfirstlane(cnt[e]); }
        return true;
    }
};

typedef int i32x8 __attribute__((ext_vector_type(8)));
__device__ __forceinline__ void mfma_f8_acc(f32x4& acc, i32x8 a, i32x8 b, int sc) {
    asm volatile("v_mfma_scale_f32_16x16x128_f8f6f4 %0, %1, %2, %0, %3, %3 op_sel_hi:[0,0,0]" : "+v"(acc) : "v"(a), "v"(b), "v"(sc));
}
template <class Epi, class Sched, int K, int lda, int ldb, bool F8 = false>
__device__ __forceinline__ void gemm_phase(LAS unsigned char* lds, const bf16_t* Abase, const bf16_t* Bbase, const Sched& S, const Epi& E, const int wave_) {
    int tid_ = wave_ * 64 + lane_id(); asm volatile("" : "+v"(tid_));
    const int tid = tid_, wid = __builtin_amdgcn_readfirstlane(tid >> 6), lane = tid & 63, wr = wid >> 2, wc = wid & 3, fr = lane & 15, fq = lane >> 4;
    constexpr int ES = F8 ? 1 : 2; constexpr int nt = K * ES / (BK * 2);
    unsigned voffA[2], voffB[2];
#pragma unroll
    for (int i = 0; i < 2; ++i) { int R, C; stage_rc(tid * 16 + i * 8192, R, C); const int Rb = Epi::PERM ? ((R & ~31) + perm32(R & 31)) : R;
        voffA[i] = (unsigned)(R * lda * ES + C * 2); voffB[i] = (unsigned)(Rb * ldb * ES + C * 2); }
    unsigned vgA_c[2][2] = {{0u, 0u}, {0u, 0u}}, vgA_n[2][2] = {{0u, 0u}, {0u, 0u}}; int Rv[2] = {0, 0}, Cv[2] = {0, 0};
    if constexpr (Sched::GATHER) {
#pragma unroll
        for (int i = 0; i < 2; ++i) stage_rc(tid * 16 + i * 8192, Rv[i], Cv[i]); }
#define PG8_GTOK(X, U) do { _Pragma("unroll") for (int _h = 0; _h < 2; ++_h) _Pragma("unroll") for (int _i = 0; _i < 2; ++_i) { int _lr = (U).glt * 256 + _h * 128 + Rv[_i]; _lr = _lr < (U).gcnt ? _lr : 0; \
        X[_h][_i] = (unsigned)S.rlist[(size_t)(U).ge * TT + _lr]; } } while (0)
#define PG8_GOFF(X) do { _Pragma("unroll") for (int _h = 0; _h < 2; ++_h) _Pragma("unroll") for (int _i = 0; _i < 2; ++_i) X[_h][_i] = X[_h][_i] * (unsigned)(lda * ES) + (unsigned)Cv[_i] * 2u; } while (0)
    constexpr size_t kstep = (size_t)(BK * 2);
    constexpr size_t hstepA = (size_t)HALF * lda * ES, hstepB = (size_t)HALF * ldb * ES;
    const unsigned ldsw = (unsigned)wid * 1024u;
    const int aoff = lds_byte(wr * 64 + fr, fq * 8), boff = lds_byte(wc * 32 + fr, fq * 8);
#define PG8_SA(b, h) (((b) * 2 + (h)) * HTB)
#define PG8_SB(b, h) ((4 + (b) * 2 + (h)) * HTB)
#define PG8_STAGE(bufoff, gbase, voff) do { _Pragma("unroll") for (int _i = 0; _i < 2; ++_i) \
        __builtin_amdgcn_global_load_lds((const unsigned*)((const char*)(gbase) + (voff)[_i]), (LAS unsigned*)(lds + (bufoff) + ldsw + _i * 8192), 16, 0, 0); } while (0)
#define PG8_STAGE_A(bufoff, gbase, h, nx) do { if constexpr (Sched::GATHER) { const unsigned _vv[2] = {(nx) ? vgA_n[h][0] : vgA_c[h][0], (nx) ? vgA_n[h][1] : vgA_c[h][1]}; PG8_STAGE(bufoff, gbase, _vv); } \
        else PG8_STAGE(bufoff, (gbase) + (h) * hstepA, voffA); } while (0)
#define PG8_LDA(dst, b, h) do { _Pragma("unroll") for (int m = 0; m < 4; ++m) _Pragma("unroll") for (int k = 0; k < 2; ++k) dst[m][k] = *(const LAS u32x4*)(lds + PG8_SA(b, h) + aoff + m * 2048 + k * 1024); } while (0)
#define PG8_LDB(dst, b, h) do { _Pragma("unroll") for (int n = 0; n < 2; ++n) _Pragma("unroll") for (int k = 0; k < 2; ++k) dst[n][k] = *(const LAS u32x4*)(lds + PG8_SB(b, h) + boff + n * 2048 + k * 1024); } while (0)
#define PG8_CAT(X, Y) __builtin_bit_cast(i32x8, __builtin_shufflevector((X), (Y), 0, 1, 2, 3, 4, 5, 6, 7))
#define PG8_MMA(ai, bj, At, Bt) do { __builtin_amdgcn_s_setprio(1); \
        if constexpr (F8) { _Pragma("unroll") for (int m = 0; m < 4; ++m) _Pragma("unroll") for (int n = 0; n < 2; ++n) \
            mfma_f8_acc(acc[ai][bj][m][n], PG8_CAT(Bt[n][0], Bt[n][1]), PG8_CAT(At[m][0], At[m][1]), f8_unit_scale); } \
        else { _Pragma("unroll") for (int m = 0; m < 4; ++m) _Pragma("unroll") for (int n = 0; n < 2; ++n) _Pragma("unroll") for (int k = 0; k < 2; ++k) \
            acc[ai][bj][m][n] = __builtin_amdgcn_mfma_f32_16x16x32_bf16(__builtin_bit_cast(bf16x8, Bt[n][k]), __builtin_bit_cast(bf16x8, At[m][k]), acc[ai][bj][m][n], 0, 0, 0); } \
        __builtin_amdgcn_s_setprio(0); } while (0)
#define PG8_WAIT_V(n) asm volatile("s_waitcnt vmcnt(" #n ")" ::: "memory")
#define PG8_WAIT_L(n) asm volatile("s_waitcnt lgkmcnt(" #n ")" ::: "memory")
#define PG8_BAR __builtin_amdgcn_s_barrier()
#define PG8_SCHED __builtin_amdgcn_sched_barrier(0)
#define PG8_KLOOP(TB, TE) do { \
        for (int t = (TB); t < (TE); t += 2) { \
            const bool last = (t == nt - 2); \
            const char* a1 = cA + (size_t)(t + 1) * kstep; \
            const char* a2 = last ? nA : cA + (size_t)(t + 2) * kstep; const char* b2 = last ? nB : cB + (size_t)(t + 2) * kstep; \
            const char* a3 = a2 + kstep; const char* b3 = b2 + kstep; \
            if constexpr (Sched::GATHER) { if (t == nt - 4) PG8_GOFF(vgA_n); } \
            PG8_LDB(B0, 0, 0); PG8_SCHED; PG8_LDA(At, 0, 0); PG8_STAGE_A(PG8_SA(1, 1), a1, 1, false); \
            PG8_WAIT_L(8); PG8_BAR; PG8_WAIT_L(0); PG8_MMA(0, 0, At, B0); PG8_BAR; PG8_SCHED; \
            PG8_LDB(B1, 0, 1); PG8_STAGE(PG8_SB(0, 0), b2, voffB); \
            PG8_BAR; PG8_WAIT_L(0); PG8_MMA(0, 1, At, B1); PG8_BAR; \
            PG8_LDA(At, 0, 1); PG8_STAGE_A(PG8_SA(0, 0), a2, 0, last); \
            PG8_BAR; PG8_WAIT_L(0); PG8_MMA(1, 0, At, B0); PG8_BAR; PG8_SCHED; \
            PG8_STAGE(PG8_SB(0, 1), b2 + hstepB, voffB); \
            PG8_WAIT_V(6); PG8_BAR; PG8_MMA(1, 1, At, B1); PG8_BAR; \
            PG8_LDB(B0, 1, 0); PG8_SCHED; PG8_LDA(At, 1, 0); PG8_STAGE_A(PG8_SA(0, 1), a2, 1, last); \
            PG8_WAIT_L(8); PG8_BAR; PG8_WAIT_L(0); PG8_MMA(0, 0, At, B0); PG8_BAR; PG8_SCHED; \
            PG8_LDB(B1, 1, 1); PG8_STAGE(PG8_SB(1, 0), b3, voffB); \
            PG8_BAR; PG8_WAIT_L(0); PG8_MMA(0, 1, At, B1); PG8_BAR; \
            PG8_LDA(At, 1, 1); PG8_STAGE_A(PG8_SA(1, 0), a3, 0, last); \
            PG8_BAR; PG8_WAIT_L(0); PG8_MMA(1, 0, At, B0); PG8_BAR; PG8_SCHED; \
            PG8_STAGE(PG8_SB(1, 1), b3 + hstepB, voffB); \
            PG8_WAIT_V(6); PG8_BAR; PG8_MMA(1, 1, At, B1); PG8_BAR; \
        } \
        } while (0)
    int f8_unit_scale = 0x7f7f7f7f; asm volatile("" : "+v"(f8_unit_scale)); (void)f8_unit_scale;
    Unit cur, nxt; int ui = 0;
    if (!S.next(0, cur)) return;
    f32x4 acc[2][2][4][2];
#pragma unroll
    for (int a = 0; a < 2; ++a)
#pragma unroll
        for (int b = 0; b < 2; ++b)
#pragma unroll
            for (int m = 0; m < 4; ++m)
#pragma unroll
                for (int n = 0; n < 2; ++n) acc[a][b][m][n] = (f32x4){0.f, 0.f, 0.f, 0.f};
    u32x4 At[4][2], B0[2][2], B1[2][2];
    const char* cA = (const char*)Abase + cur.aoff; const char* cB = (const char*)Bbase + cur.boff;
    if constexpr (Sched::GATHER) { PG8_GTOK(vgA_c, cur); PG8_GOFF(vgA_c); }
    PG8_STAGE(PG8_SB(0, 0), cB, voffB); PG8_STAGE_A(PG8_SA(0, 0), cA, 0, false); PG8_STAGE(PG8_SB(0, 1), cB + hstepB, voffB); PG8_STAGE_A(PG8_SA(0, 1), cA, 1, false);
    if (wr == 1) PG8_BAR;
    PG8_WAIT_V(4); PG8_BAR;
    PG8_STAGE(PG8_SB(1, 0), cB + kstep, voffB); PG8_STAGE_A(PG8_SA(1, 0), cA + kstep, 0, false); PG8_STAGE(PG8_SB(1, 1), cB + hstepB + kstep, voffB);
    PG8_WAIT_V(6); PG8_BAR;
    for (;;) {
        const bool has_next = S.next(ui + 1, nxt);
        const char* nA = has_next ? (const char*)Abase + nxt.aoff : cA; const char* nB = has_next ? (const char*)Bbase + nxt.boff : cB;
        if constexpr (Sched::GATHER) { if (has_next) PG8_GTOK(vgA_n, nxt); else PG8_GTOK(vgA_n, cur); }
        if constexpr (Epi::MID) {
            constexpr int t1 = 1024 * ES / (BK * 2), t2 = 1536 * ES / (BK * 2);
            PG8_KLOOP(0, t1); if constexpr (F8) asm volatile("s_nop 7\n\ts_nop 7\n\ts_nop 7" ::: "memory"); E.mid(acc, cur, 0, wr, wc, fr, fq);
            PG8_KLOOP(t1, t2); if constexpr (F8) asm volatile("s_nop 7\n\ts_nop 7\n\ts_nop 7" ::: "memory"); E.mid(acc, cur, 1, wr, wc, fr, fq); PG8_KLOOP(t2, nt);
        } else { PG8_KLOOP(0, nt); }
        if constexpr (F8) asm volatile("s_nop 7\n\ts_nop 7\n\ts_nop 7" ::: "memory");
        E(acc, cur, wr, wc, fr, fq);
        if (!has_next) break;
#pragma unroll
        for (int a = 0; a < 2; ++a)
#pragma unroll
            for (int b = 0; b < 2; ++b)
#pragma unroll
                for (int m = 0; m < 4; ++m)
#pragma unroll
                    for (int n = 0; n < 2; ++n) acc[a][b][m][n] = (f32x4){0.f, 0.f, 0.f, 0.f};
        cur = nxt; cA = nA; cB = nB; ++ui;
        if constexpr (Sched::GATHER) {
#pragma unroll
            for (int _h = 0; _h < 2; ++_h)
#pragma unroll
                for (int _i = 0; _i < 2; ++_i) vgA_c[_h][_i] = vgA_n[_h][_i]; }
    }
    PG8_WAIT_V(0);
    if (wr == 0) PG8_BAR;
    PG8_BAR;
#undef PG8_KLOOP
#undef PG8_GTOK
#undef PG8_GOFF
#undef PG8_STAGE_A
#undef PG8_SA
#undef PG8_SB
#undef PG8_STAGE
#undef PG8_LDA
#undef PG8_LDB
#undef PG8_MMA
#undef PG8_CAT
#undef PG8_WAIT_V
#undef PG8_WAIT_L
#undef PG8_BAR
#undef PG8_SCHED
}
}

typedef f32x4 AccT[2][2][4][2];
struct EpiBf16 {
    static constexpr bool PERM = true, MID = false;
    bf16_t* O; int ldc; int sig_lo, sig_hi;
    int split_pn; bf16_t* O2; int ldc2;
    float* ssq_acc; int ssq_tiles;
    unsigned char* cq8; float cs2;
    unsigned char* gt8;
    const float* rs; float rs_inv_n;
    __device__ __forceinline__ void operator()(const AccT& acc, const pg8::Unit& u, int wr, int wc, int fr, int fq) const {
        const int row0 = u.pm * 256 + wr * 64 + fr;
        const bool second = u.pn >= split_pn;
        if (ssq_acc && u.pn < ssq_tiles) {
#pragma unroll
            for (int ai = 0; ai < 2; ++ai)
#pragma unroll
                for (int m = 0; m < 4; ++m) { float sq = 0.f;
#pragma unroll
                    for (int bj = 0; bj < 2; ++bj)
#pragma unroll
                        for (int n = 0; n < 2; ++n) { const f32x4 v = acc[ai][bj][m][n]; sq += (v[0] * v[0] + v[1] * v[1]) + (v[2] * v[2] + v[3] * v[3]); }
                    sq += __shfl_xor(sq, 16); sq += __shfl_xor(sq, 32); if (!rs && rs_inv_n != 0.f) sq *= rs_inv_n * rs_inv_n;
                    if (fq == 0) ssq_acc[(size_t)(row0 + ai * 128 + m * 16) * 16 + (u.pn >> 1) * 8 + (u.pn & 1) * 4 + wc] = sq; } }
        float rsc[2][4];
#pragma unroll
        for (int ai = 0; ai < 2; ++ai)
#pragma unroll
            for (int m = 0; m < 4; ++m) { rsc[ai][m] = (!rs && rs_inv_n != 0.f) ? rs_inv_n : 1.0f;
                if (rs) { const f32x4* pq = (const f32x4*)(rs + (size_t)(row0 + ai * 128 + m * 16) * 16 + (second ? 8 : 0)); const f32x4 a = pq[0], b = pq[1];
                    rsc[ai][m] = rsqrtf((((a[0] + a[1]) + (a[2] + a[3])) + ((b[0] + b[1]) + (b[2] + b[3]))) * rs_inv_n + EPS) * cs2; } }
        if (cq8 && ssq_acc && u.pn < ssq_tiles) {
            unsigned char* tp = cq8 + (size_t)row0 * 1024 + u.pn * 256 + wc * 32 + 8 * fq;
#pragma unroll
            for (int ai = 0; ai < 2; ++ai)
#pragma unroll
                for (int m = 0; m < 4; ++m)
#pragma unroll
                    for (int bj = 0; bj < 2; ++bj) { const f32x4 v0 = acc[ai][bj][m][0] * rsc[ai][m], v1 = acc[ai][bj][m][1] * rsc[ai][m];
                        u32x2 w; w.x = pk4_fp8(v0[0], v0[1], v0[2], v0[3]); w.y = pk4_fp8(v1[0], v1[1], v1[2], v1[3]);
                        *(u32x2*)(tp + (size_t)(ai * 128 + m * 16) * 1024 + bj * 128) = w; }
            return; }
        bf16_t* base = second ? O2 : O; const int ld = second ? ldc2 : ldc; const int pn = second ? u.pn - split_pn : u.pn;
        const int col0 = pn * 256 + wc * 32 + 8 * fq;
        const bool sig = (u.pn >= sig_lo) && (u.pn < sig_hi);
        if (sig && gt8 && u.pm < 32) {
            unsigned char* tp = gt8 + ((size_t)(u.pm * 24 + (u.pn - sig_lo)) * 8 + (wr * 4 + wc)) * 8192 + (fq * 16 + fr) * 8;
#pragma unroll
            for (int ai = 0; ai < 2; ++ai)
#pragma unroll
                for (int m = 0; m < 4; ++m)
#pragma unroll
                    for (int bj = 0; bj < 2; ++bj) { u32x2 w; unsigned b[8];
#pragma unroll
                        for (int j = 0; j < 4; ++j) { b[j] = (unsigned)fminf(sigmoidf_(acc[ai][bj][m][0][j] * rsc[ai][m]) * 256.0f, 255.0f); b[4 + j] = (unsigned)fminf(sigmoidf_(acc[ai][bj][m][1][j] * rsc[ai][m]) * 256.0f, 255.0f); }
                        w.x = b[0] | (b[1] << 8) | (b[2] << 16) | (b[3] << 24); w.y = b[4] | (b[5] << 8) | (b[6] << 16) | (b[7] << 24);
                        *(u32x2*)(tp + ((ai * 4 + m) * 2 + bj) * 512) = w; }
            return; }
#pragma unroll
        for (int ai = 0; ai < 2; ++ai)
#pragma unroll
            for (int m = 0; m < 4; ++m) { bf16_t* rowp = base + (size_t)(row0 + ai * 128 + m * 16) * ld + col0;
#pragma unroll
                for (int bj = 0; bj < 2; ++bj) { f32x4 v0 = acc[ai][bj][m][0] * rsc[ai][m], v1 = acc[ai][bj][m][1] * rsc[ai][m];
                    if (sig) {
#pragma unroll
                        for (int j = 0; j < 4; ++j) { v0[j] = sigmoidf_(v0[j]); v1[j] = sigmoidf_(v1[j]); } }
                    u32x4 w; w.x = cvt_pk_bf16(v0[0], v0[1]); w.y = cvt_pk_bf16(v0[2], v0[3]); w.z = cvt_pk_bf16(v1[0], v1[1]); w.w = cvt_pk_bf16(v1[2], v1[3]);
                    *(u32x4*)(rowp + bj * 128) = w; } }
    }
};
struct EpiDown {
    static constexpr bool PERM = true, MID = false;
    bf16_t* O;
    __device__ __forceinline__ void operator()(const AccT& acc, const pg8::Unit& u, int wr, int wc, int fr, int fq) const {
        bf16_t* base = O + (size_t)(u.pm * 256 + wr * 64 + fr) * DM + u.pn * 256 + wc * 32 + 8 * fq;
#pragma unroll
        for (int ai = 0; ai < 2; ++ai)
#pragma unroll
            for (int m = 0; m < 4; ++m)
#pragma unroll
                for (int bj = 0; bj < 2; ++bj) { const f32x4 v0 = acc[ai][bj][m][0] * (1.0f / 32), v1 = acc[ai][bj][m][1] * (1.0f / 32);
                    u32x4 w; w.x = cvt_pk_bf16(v0[0], v0[1]); w.y = cvt_pk_bf16(v0[2], v0[3]); w.z = cvt_pk_bf16(v1[0], v1[1]); w.w = cvt_pk_bf16(v1[2], v1[3]);
                    *(u32x4*)(base + (size_t)(ai * 128 + m * 16) * DM + bj * 128) = w; }
    }
};
struct EpiMerge {
    static constexpr bool PERM = true, MID = true;
    const unsigned char* gt8; int ldg_unused; bf16_t* y; unsigned char* y8; float ys;
    __device__ __forceinline__ void scale_by(AccT& acc, const pg8::Unit& u, int gnum, int gden, int wr, int wc, int fr, int fq) const {
        unsigned loff = (unsigned)(((wr * 4 + wc) * 8192) + (fq * 16 + fr) * 8); asm volatile("" : "+v"(loff));
        const unsigned char* nb = gt8 + (size_t)(u.pm * 24 + gnum + u.pn) * 65536; const unsigned char* db = gt8 + (size_t)(u.pm * 24 + (gden < 0 ? gnum : gden) + u.pn) * 65536;
        u32x2 nw[2][4][2], dw[2][4][2];
#pragma unroll
        for (int ai = 0; ai < 2; ++ai)
#pragma unroll
            for (int m = 0; m < 4; ++m)
#pragma unroll
                for (int bj = 0; bj < 2; ++bj) { nw[ai][m][bj] = *(const u32x2*)(nb + loff + ((ai * 4 + m) * 2 + bj) * 512); if (gden >= 0) dw[ai][m][bj] = *(const u32x2*)(db + loff + ((ai * 4 + m) * 2 + bj) * 512); }
#pragma unroll
        for (int ai = 0; ai < 2; ++ai)
#pragma unroll
            for (int m = 0; m < 4; ++m)
#pragma unroll
                for (int bj = 0; bj < 2; ++bj) { float nf[8];
#pragma unroll
                    for (int j = 0; j < 4; ++j) { nf[j] = (float)((nw[ai][m][bj].x >> (8 * j)) & 0xffu) + 0.5f; nf[4 + j] = (float)((nw[ai][m][bj].y >> (8 * j)) & 0xffu) + 0.5f; }
                    if (gden >= 0) {
#pragma unroll
                        for (int j = 0; j < 4; ++j) { nf[j] *= __builtin_amdgcn_rcpf((float)((dw[ai][m][bj].x >> (8 * j)) & 0xffu) + 0.5f); nf[4 + j] *= __builtin_amdgcn_rcpf((float)((dw[ai][m][bj].y >> (8 * j)) & 0xffu) + 0.5f); } }
                    else {
#pragma unroll
                        for (int j = 0; j < 8; ++j) nf[j] *= (1.0f / 256); }
#pragma unroll
                    for (int j = 0; j < 4; ++j) { acc[ai][bj][m][0][j] *= nf[j]; acc[ai][bj][m][1][j] *= nf[4 + j]; } }
    }
    __device__ __forceinline__ void mid(AccT& acc, const pg8::Unit& u, int t, int wr, int wc, int fr, int fq) const {
        if (t == 0) scale_by(acc, u, 0, 8, wr, wc, fr, fq); else scale_by(acc, u, 8, 16, wr, wc, fr, fq);
    }
    __device__ __forceinline__ void operator()(AccT& acc, const pg8::Unit& u, int wr, int wc, int fr, int fq) const {
        scale_by(acc, u, 16, -1, wr, wc, fr, fq);
        const int row0 = u.pm * 256 + wr * 64 + fr, col0 = u.pn * 256 + wc * 32 + 8 * fq;
#pragma unroll
        for (int ai = 0; ai < 2; ++ai)
#pragma unroll
            for (int m = 0; m < 4; ++m) { unsigned char* rowp = y8 + (size_t)(row0 + ai * 128 + m * 16) * DM + col0;
#pragma unroll
                for (int bj = 0; bj < 2; ++bj) { const f32x4 v0 = acc[ai][bj][m][0] * ys, v1 = acc[ai][bj][m][1] * ys;
                    u32x2 w; w.x = pk4_fp8(v0[0], v0[1], v0[2], v0[3]); w.y = pk4_fp8(v1[0], v1[1], v1[2], v1[3]);
                    *(u32x2*)(rowp + bj * 128) = w; } }
    }
};
template <bool XB>
struct EpiOut {
    static constexpr bool PERM = true, MID = false;
    const void* xlat; const void* xctx;
    const float* modl;
    bf16_t* xmid; float cs;
    __device__ __forceinline__ void operator()(const AccT& acc, const pg8::Unit& u, int wr, int wc, int fr, int fq) const {
        constexpr int XE = XB ? 2 : 4;
        const int rt = u.pm * 256; const bool lat = rt < TL; const int v = lat ? (rt >> 12) : 2;
        const char* xs = (const char*)(lat ? xlat : xctx) + (size_t)(lat ? rt : rt - TL) * DM * XE;
        char* xo = (char*)(xmid + (size_t)rt * DM);
        const int col0 = u.pn * 256 + wc * 32 + 8 * fq;
        const float* g1 = modl + (size_t)v * 6 * DM + 2 * DM + col0;
        f32x4 g[2][2];
#pragma unroll
        for (int bj = 0; bj < 2; ++bj)
#pragma unroll
            for (int n = 0; n < 2; ++n) g[bj][n] = *(const f32x4*)(g1 + bj * 128 + n * 4) * cs;
        unsigned loff = (unsigned)((wr * 64 + fr) * DM + col0); asm volatile("" : "+v"(loff));
#pragma unroll
        for (int ai = 0; ai < 2; ++ai) {
            f32x4 xr[4][2][2];
#pragma unroll
            for (int m = 0; m < 4; ++m)
#pragma unroll
                for (int bj = 0; bj < 2; ++bj) { const unsigned e = loff + (unsigned)((ai * 128 + m * 16) * DM + bj * 128);
                    if constexpr (XB) { const u32x4 w = *(const u32x4*)(xs + (size_t)e * 2);
                        xr[m][bj][0] = (f32x4){bf_lo(w.x), bf_hi(w.x), bf_lo(w.y), bf_hi(w.y)}; xr[m][bj][1] = (f32x4){bf_lo(w.z), bf_hi(w.z), bf_lo(w.w), bf_hi(w.w)}; }
                    else { xr[m][bj][0] = *(const f32x4*)(xs + (size_t)e * 4); xr[m][bj][1] = *(const f32x4*)(xs + (size_t)e * 4 + 16); } }
#pragma unroll
            for (int m = 0; m < 4; ++m)
#pragma unroll
                for (int bj = 0; bj < 2; ++bj) { const unsigned e = loff + (unsigned)((ai * 128 + m * 16) * DM + bj * 128);
                    const f32x4 v0 = xr[m][bj][0] + g[bj][0] * acc[ai][bj][m][0], v1 = xr[m][bj][1] + g[bj][1] * acc[ai][bj][m][1];
                    u32x4 w; w.x = cvt_pk_bf16(v0[0], v0[1]); w.y = cvt_pk_bf16(v0[2], v0[3]); w.z = cvt_pk_bf16(v1[0], v1[1]); w.w = cvt_pk_bf16(v1[2], v1[3]);
                    *(u32x4*)(xo + (size_t)e * 2) = w; }
            asm volatile("" ::: "memory");
        }
    }
};
struct EpiMoe1 {
    static constexpr bool PERM = true, MID = false;
    unsigned char* H; float WS;
    __device__ __forceinline__ void operator()(const AccT& acc, const pg8::Unit& u, int wr, int wc, int fr, int fq) const {
        const int row0 = u.pm * 256 + wr * 64 + fr, col0 = u.pn * 128 + wc * 32 + 8 * fq;
#pragma unroll
        for (int ai = 0; ai < 2; ++ai)
#pragma unroll
            for (int m = 0; m < 4; ++m) { unsigned char* rowp = H + (size_t)(row0 + ai * 128 + m * 16) * MOE_H + col0;
                f32x4 h0, h1;
#pragma unroll
                for (int j = 0; j < 4; ++j) { h0[j] = siluf_(acc[ai][0][m][0][j] * WS) * (acc[ai][1][m][0][j] * WS); h1[j] = siluf_(acc[ai][0][m][1][j] * WS) * (acc[ai][1][m][1][j] * WS); }
                u32x2 w; w.x = pk4_fp8(h0[0], h0[1], h0[2], h0[3]); w.y = pk4_fp8(h1[0], h1[1], h1[2], h1[3]);
                *(u32x2*)rowp = w; }
    }
};

#define KSWZ(row, colB) ((row) * 256 + ((colB) ^ (((row) & 7) << 4)))
__device__ __forceinline__ int crow(int r, int hi) { return (r & 3) + 8 * (r >> 2) + 4 * hi; }
__device__ __forceinline__ int v_st(int k, int c) { const int kk = (k & ~0xC) | ((k & 4) << 1) | ((k & 8) >> 1); return ((kk >> 3) * 4 + (c >> 5)) * 512 + ((kk & 7) * 32 + (c & 31)) * 2; }
__device__ __forceinline__ int v_rd_base(int lane) { return ((lane & 3) << 3) | (((lane >> 2) & 3) << 6) | (((lane >> 4) & 1) << 5) | (((lane >> 5) & 1) << 8); }
constexpr int v_rd_off(int d0, int ks, int half) { return d0 * 512 + ks * 4096 + half * 2048; }
template <int OFF> __device__ __forceinline__ s16x4 tr_read(int vb) {
    s16x4 r; asm volatile("ds_read_b64_tr_b16 %0, %1 offset:%2" : "=&v"(r) : "v"(vb), "i"(OFF) : "memory"); return r;
}
struct VFrag { s16x4 l0, h0, l1, h1; };
template <int D0, int HF> __device__ __forceinline__ void pv_reads(VFrag& v, int vb) {
    v.l0 = tr_read<v_rd_off(D0, 2 * HF, 0)>(vb); v.h0 = tr_read<v_rd_off(D0, 2 * HF, 1)>(vb); v.l1 = tr_read<v_rd_off(D0, 2 * HF + 1, 0)>(vb); v.h1 = tr_read<v_rd_off(D0, 2 * HF + 1, 1)>(vb);
}
__device__ __forceinline__ void pv_mma(f32x16& od, const VFrag& v, bf16x8 pa0, bf16x8 pa1) {
#define PKV(L, H) (bf16x8){L[0], L[1], L[2], L[3], H[0], H[1], H[2], H[3]}
    od = __builtin_amdgcn_mfma_f32_32x32x16_bf16(pa0, PKV(v.l0, v.h0), od, 0, 0, 0);
    od = __builtin_amdgcn_mfma_f32_32x32x16_bf16(pa1, PKV(v.l1, v.h1), od, 0, 0, 0);
#undef PKV
}

struct AttnCx {
    const bf16_t* Qb; int ldq;
    int qwoff;
    const bf16_t* Kb; int ldk; const bf16_t* Vb; int ldv;
    bf16_t* Ob; int ldo; int owoff; unsigned char* Ob8;
    int qtok0;
    int qmap;
    int nt, nloc, ktok_loc0, ktok_ctx0;
    float scale_l2;
    int na_r0, na_kr0; const float* bias;
    const float* mq_gain; const float2* mq_rope;
    int gq_pos0, gq_kpos0; const float* sink; int local;
};
__device__ __forceinline__ int attn_qtok(const AttnCx& cx, int w, int r32) {
    return cx.qmap == 0 ? cx.qtok0 + w * 32 + r32 : (cx.qmap == 1 ? cx.qtok0 + (w >> 1) * 64 + (w & 1) * 32 + r32 : cx.qtok0 + (w & 1) * 32 + r32);
}

typedef int i32x8 __attribute__((ext_vector_type(8)));
__device__ __forceinline__ constexpr int qk_off(int c, int hi) { return c < 4 ? (c >> 1) * 64 + hi * 32 + (c & 1) * 16 : 128 + (c & 1) * 32 + hi * 16; }
constexpr int K8LD = 208;
constexpr int V8LD = 80;
constexpr float P8THR = 8.0f, P8OFF = 5.0f;
template <int DQ, int DV, int MODE>
__device__ __forceinline__ void attn_item(char* lds, const AttnCx& cx, const int wave_) {
    constexpr int ND0 = DQ / 16, NDV = DV / 32, CPR = DQ / 8, NKC = 64 * CPR / 512, CPRV = DV / 8, NVC = 64 * CPRV / 512;
    constexpr int KBUF = 32768, VBUF = 16384;
    int tid_ = wave_ * 64 + lane_id(); asm volatile("" : "+v"(tid_));
    const int tid = tid_, wid = __builtin_amdgcn_readfirstlane(tid >> 6), lane = tid & 63, r32 = lane & 31, hi = lane >> 5;
    char* Kl = lds; char* Vl = lds + 2 * KBUF;
    float* scr = (float*)(lds + 2 * KBUF + 2 * VBUF) + wid * 64; float* li_l = scr; float* al_l = scr + 32;
    const bf16_t* qp = cx.Qb + (size_t)attn_qtok(cx, wid, r32) * cx.ldq + (wid >> 1) * cx.qwoff + hi * 8;
    bf16x8 qr[ND0]; i32x8 qf[3]; int f8sc = 0x7f7f7f7f; (void)qf; (void)f8sc;
    if constexpr (MODE != 0) {
#pragma unroll
        for (int d0 = 0; d0 < ND0; ++d0) qr[d0] = *(const bf16x8*)(qp + d0 * 16);
    }
    if constexpr (MODE == 0) {
        const int qtok = attn_qtok(cx, wid, r32); const bool lat = qtok < TL; const float2* cs = cx.mq_rope + (size_t)(qtok & (SEQ - 1)) * 32 + hi * 16;
        const bf16_t* q0 = cx.Qb + (size_t)qtok * cx.ldq;
        float qv[6][16];
#pragma unroll
        for (int c = 0; c < 6; ++c) { const int d = c < 4 ? (c >> 1) * 64 + hi * 32 + (c & 1) * 16 : 128 + (c & 1) * 32 + hi * 16;
            const u32x4 w0 = *(const u32x4*)(q0 + d), w1 = *(const u32x4*)(q0 + d + 8);
            float f[8]; unpack8(w0, f);
#pragma unroll
            for (int e = 0; e < 8; ++e) qv[c][e] = f[e];
            unpack8(w1, f);
#pragma unroll
            for (int e = 0; e < 8; ++e) qv[c][8 + e] = f[e]; }
        float ss = 0.f;
#pragma unroll
        for (int c = 0; c < 6; ++c)
#pragma unroll
            for (int e = 0; e < 16; ++e) ss += qv[c][e] * qv[c][e];
        { auto rr = __builtin_amdgcn_permlane32_swap(__float_as_uint(ss), __float_as_uint(ss), false, false); ss = __uint_as_float(rr[0]) + __uint_as_float(rr[1]); }
        const float rn = rsqrtf(ss * (1.0f / 192) + EPS);
#pragma unroll
        for (int c = 0; c < 6; ++c) { const int d = c < 4 ? (c >> 1) * 64 + hi * 32 + (c & 1) * 16 : 128 + (c & 1) * 32 + hi * 16; const float* g = cx.mq_gain + d;
#pragma unroll
            for (int e = 0; e < 16; ++e) qv[c][e] *= rn * g[e]; }
        if (lat) {
#pragma unroll
            for (int e = 0; e < 16; ++e) { const float x1 = qv[4][e], x2 = qv[5][e]; const float2 c = cs[e]; qv[4][e] = x1 * c.x - x2 * c.y; qv[5][e] = x1 * c.y + x2 * c.x; } }
#pragma unroll
        for (int m = 0; m < 3; ++m) { i32x8 w;
#pragma unroll
            for (int k = 0; k < 2; ++k)
#pragma unroll
                for (int q4 = 0; q4 < 4; ++q4) w[k * 4 + q4] = (int)pk4_fp8(qv[2 * m + k][q4 * 4], qv[2 * m + k][q4 * 4 + 1], qv[2 * m + k][q4 * 4 + 2], qv[2 * m + k][q4 * 4 + 3]);
            qf[m] = w; }
        asm volatile("" : "+v"(f8sc));
    }
    f32x16 o[NDV];
#pragma unroll
    for (int d = 0; d < NDV; ++d)
#pragma unroll
        for (int r = 0; r < 16; ++r) o[d][r] = 0.f;
    float m_reg = -1e30f, l_reg = 0.f;
    bf16x8 ks[NKC], vs[NVC];
    const int vb0 = (int)(uintptr_t)Vl + v_rd_base(lane);
#define AT_TOK(t) ((t) < cx.nloc ? cx.ktok_loc0 + (t) * 64 : cx.ktok_ctx0 + ((t) - cx.nloc) * 64)
#define AT_LOAD(t) do { const int _tok = AT_TOK(t); \
    if constexpr (MODE == 0) { const unsigned char* _kb = (const unsigned char*)cx.Kb;     \
        { const int row = tid / 12, c = tid % 12; ks[0] = *(const bf16x8*)(_kb + (size_t)(_tok + row) * cx.ldk + c * 16); } \
        if (tid < 256) { const int ci = 512 + tid, row = ci / 12, c = ci % 12; ks[1] = *(const bf16x8*)(_kb + (size_t)(_tok + row) * cx.ldk + c * 16); } } \
    else { _Pragma("unroll") for (int _i = 0; _i < NKC; ++_i) { const int ci = tid + _i * 512, row = ci / CPR, c8 = ci % CPR; ks[_i] = *(const bf16x8*)(cx.Kb + (size_t)(_tok + row) * cx.ldk + c8 * 8); } } \
    if constexpr (MODE == 0) { vs[0] = *(const bf16x8*)((const unsigned char*)cx.Vb + (size_t)(_tok >> 6) * 65536 + tid * 16); }     \
    else { _Pragma("unroll") for (int _i = 0; _i < NVC; ++_i) { const int ci = tid + _i * 512, row = ci / CPRV, c8 = ci % CPRV; vs[_i] = *(const bf16x8*)(cx.Vb + (size_t)(_tok + row) * cx.ldv + c8 * 8); } } } while (0)
#define AT_WRITE(b) do { \
    if constexpr (MODE == 0) { { const int row = tid / 12, c = tid % 12; *(bf16x8*)(Kl + (b) * KBUF + row * K8LD + c * 16) = ks[0]; } \
        if (tid < 256) { const int ci = 512 + tid, row = ci / 12, c = ci % 12; *(bf16x8*)(Kl + (b) * KBUF + row * K8LD + c * 16) = ks[1]; } } \
    else { _Pragma("unroll") for (int _i = 0; _i < NKC; ++_i) { const int ci = tid + _i * 512, row = ci / CPR, dim = (ci % CPR) * 8; *(bf16x8*)(Kl + (b) * KBUF + (dim >> 7) * 16384 + KSWZ(row, (dim & 127) * 2)) = ks[_i]; } } \
    if constexpr (MODE == 0) { *(bf16x8*)(Vl + (b) * VBUF + (tid >> 2) * V8LD + (tid & 3) * 16) = vs[0]; } \
    else { _Pragma("unroll") for (int _i = 0; _i < NVC; ++_i) { const int ci = tid + _i * 512, row = ci / CPRV, c = (ci % CPRV) * 8; *(bf16x8*)(Vl + (b) * VBUF + v_st(row, c)) = vs[_i]; } } } while (0)
    AT_LOAD(0); AT_WRITE(0); __syncthreads();
    const int nt = cx.nt;
    const int wq = wid >> 1, wh = wid & 1;
    const int na_r = cx.na_r0 + wq, na_rs = min(max(na_r - 4, 0), 56), na_c = wh * 32 + r32, na_cs = min(max(na_c - 8, 0), 48);
    const int gq_pos = cx.gq_pos0 + wh * 32 + r32;
    if constexpr (MODE == 0) {
        const float Cs = cx.scale_l2; const int NH = 2 * nt;
        if (nt > 1) AT_LOAD(1);
        f32x16 sc, sn; float al_c;
#define AT_QK(S, KT, HF) do { _Pragma("unroll") for (int r = 0; r < 16; ++r) S[r] = 0.f; \
        const char* _kr = (KT) + ((HF) * 32 + r32) * K8LD + hi * 32; \
        _Pragma("unroll") for (int m = 0; m < 3; ++m) { const int o0 = m < 2 ? m * 64 : 128 - hi * 16, o1 = m < 2 ? m * 64 + 16 : 160 - hi * 16; \
            const u32x4 k0 = *(const u32x4*)(_kr + o0), k1 = *(const u32x4*)(_kr + o1); \
            S = __builtin_amdgcn_mfma_scale_f32_32x32x64_f8f6f4(__builtin_bit_cast(i32x8, __builtin_shufflevector(k0, k1, 0, 1, 2, 3, 4, 5, 6, 7)), qf[m], S, 0, 0, 0, f8sc, 0, f8sc); } } while (0)
#define AT_PARTIAL(S, AL) do { float pmax = S[0]; _Pragma("unroll") for (int r = 1; r < 16; ++r) pmax = fmaxf(pmax, S[r]); \
        { auto rr = __builtin_amdgcn_permlane32_swap(__float_as_uint(pmax), __float_as_uint(pmax), false, false); pmax = fmaxf(__uint_as_float(rr[0]), __uint_as_float(rr[1])); } \
        pmax *= Cs; float mn = m_reg; AL = 1.f; if (!__all(pmax - m_reg <= P8THR)) { mn = fmaxf(m_reg, pmax - P8OFF); AL = __builtin_amdgcn_exp2f(m_reg - mn); m_reg = mn; } \
        _Pragma("unroll") for (int r = 0; r < 16; ++r) S[r] = fmaf(S[r], Cs, -mn); } while (0)
        AT_QK(sc, Kl, 0); AT_PARTIAL(sc, al_c);
        u32x4 p_lo = {0u, 0u, 0u, 0u}, p_hi = {0u, 0u, 0u, 0u};
        const char* v8b = Vl + r32 * V8LD + hi * 32;
#define AT_PV2(D0, VR) do { const u32x4 a0 = *(const u32x4*)((VR) + (D0) * 32 * V8LD), a1 = *(const u32x4*)((VR) + (D0) * 32 * V8LD + 16); \
              const u32x4 b0 = *(const u32x4*)((VR) + ((D0) + 1) * 32 * V8LD), b1 = *(const u32x4*)((VR) + ((D0) + 1) * 32 * V8LD + 16); \
              asm volatile("s_waitcnt lgkmcnt(0)" ::: "memory"); __builtin_amdgcn_sched_barrier(0); \
              o[D0] = __builtin_amdgcn_mfma_scale_f32_32x32x64_f8f6f4(pA, __builtin_bit_cast(i32x8, __builtin_shufflevector(a0, a1, 0, 1, 2, 3, 4, 5, 6, 7)), o[D0], 0, 0, 0, f8sc, 0, f8sc); \
              o[(D0) + 1] = __builtin_amdgcn_mfma_scale_f32_32x32x64_f8f6f4(pA, __builtin_bit_cast(i32x8, __builtin_shufflevector(b0, b1, 0, 1, 2, 3, 4, 5, 6, 7)), o[(D0) + 1], 0, 0, 0, f8sc, 0, f8sc); } while (0)
#define AT_STEP(H, NEXT) do { \
            const int t = j >> 1, buf = t & 1; \
            if (NEXT) { if (H == 0) AT_QK(sn, Kl + buf * KBUF, 1); else AT_QK(sn, Kl + (buf ^ 1) * KBUF, 0); } \
            _Pragma("unroll") for (int r = 0; r < 16; ++r) sc[r] = __builtin_amdgcn_exp2f(sc[r]); \
            float ps = 0.f; \
            _Pragma("unroll") for (int r = 0; r < 16; ++r) ps += sc[r]; \
            { auto rr = __builtin_amdgcn_permlane32_swap(__float_as_uint(ps), __float_as_uint(ps), false, false); ps = __uint_as_float(rr[0]) + __uint_as_float(rr[1]); } \
            l_reg = l_reg * al_c + ps; \
            { u32x4 pw; pw.x = pk4_fp8_nc(sc[0], sc[1], sc[2], sc[3]); pw.y = pk4_fp8_nc(sc[4], sc[5], sc[6], sc[7]); pw.z = pk4_fp8_nc(sc[8], sc[9], sc[10], sc[11]); pw.w = pk4_fp8_nc(sc[12], sc[13], sc[14], sc[15]);     \
              if (H == 0) p_lo = pw; else p_hi = pw; } \
            if (__any(al_c < 1.f)) { \
                if (hi == 0) al_l[r32] = al_c; \
                asm volatile("s_waitcnt lgkmcnt(0)" ::: "memory"); \
                _Pragma("unroll") for (int r = 0; r < 16; ++r) { const float a = al_l[crow(r, hi)]; _Pragma("unroll") for (int d = 0; d < NDV; ++d) o[d][r] *= a; } \
                if (H == 1) {     \
                    _Pragma("unroll") for (int q4 = 0; q4 < 4; ++q4) { const int w = (int)p_lo[q4]; \
                        p_lo[q4] = pk4_fp8(__builtin_amdgcn_cvt_f32_fp8(w, 0) * al_c, __builtin_amdgcn_cvt_f32_fp8(w, 1) * al_c, __builtin_amdgcn_cvt_f32_fp8(w, 2) * al_c, __builtin_amdgcn_cvt_f32_fp8(w, 3) * al_c); } } \
            } \
            if (H == 1) { const char* vr = v8b + buf * VBUF; const i32x8 pA = __builtin_bit_cast(i32x8, __builtin_shufflevector(p_lo, p_hi, 0, 1, 2, 3, 4, 5, 6, 7)); \
              AT_PV2(0, vr); AT_PV2(2, vr); } \
            if (NEXT) { AT_PARTIAL(sn, al_c); _Pragma("unroll") for (int r = 0; r < 16; ++r) sc[r] = sn[r]; } \
            if (H == 0) { if (t + 1 < nt) { AT_WRITE(buf ^ 1); if (t + 2 < nt) AT_LOAD(t + 2); } } \
            __syncthreads(); } while (0)
        for (int j = 0; j < NH - 2; j += 2) { AT_STEP(0, true); { const int j0 = j; const int j = j0 + 1; AT_STEP(1, true); } }
        { const int j = NH - 2; AT_STEP(0, true); }
        { const int j = NH - 1; AT_STEP(1, false); }
#undef AT_PV2
#undef AT_STEP
#undef AT_QK
#undef AT_PARTIAL
    } else
    for (int t = 0; t < nt; ++t) {
        const int buf = t & 1;
        if (t + 1 < nt) AT_LOAD(t + 1);
        bool skip = false;
        if (MODE == 1) { if (t < cx.nloc) { const int kr = cx.na_kr0 + t; skip = (kr < na_rs) || (kr >= na_rs + 8); } }
        if (MODE == 2) { if (cx.local && t < cx.nloc) { const int kp0 = cx.gq_kpos0 + t * 64; const int q0 = cx.gq_pos0 + wh * 32; skip = (kp0 + 63 < q0 - 128) || (kp0 > q0 + 31 + 128); } }
        if (!skip) {
            const char* Kt = Kl + buf * KBUF; const int vb = vb0 + buf * VBUF; const float Cs = cx.scale_l2;
#pragma unroll
            for (int hf = 0; hf < 2; ++hf) {
                f32x16 pp;
#pragma unroll
                for (int r = 0; r < 16; ++r) pp[r] = 0.f;
#pragma unroll
                for (int d0 = 0; d0 < ND0; ++d0) { const int pan = d0 >> 3, cb = ((d0 & 7) * 16 + hi * 8) * 2;
                    const bf16x8 bk = *(const bf16x8*)(Kt + pan * 16384 + KSWZ(hf * 32 + r32, cb));
                    pp = __builtin_amdgcn_mfma_f32_32x32x16_bf16(bk, qr[d0], pp, 0, 0, 0); }
                VFrag vf[2];
                if (hf == 0) { pv_reads<0, 0>(vf[0], vb); pv_reads<1, 0>(vf[1], vb); } else { pv_reads<0, 1>(vf[0], vb); pv_reads<1, 1>(vf[1], vb); }
                if (MODE == 1 && t < cx.nloc) {
                    int na_cs_t = na_cs; asm volatile("" : "+v"(na_cs_t));
                    const int kr = cx.na_kr0 + t; const float* brow = cx.bias + (kr - na_r + 7) * 31 + 15 - na_c;
#pragma unroll
                    for (int r = 0; r < 16; ++r) { const int kc = hf * 32 + crow(r, hi);
                        const bool v = (kc >= na_cs_t) && (kc < na_cs_t + 16);
                        const float bb = brow[v ? kc : na_c];
                        pp[r] = v ? fmaf(pp[r], Cs, bb) : -INFINITY; }
                } else if (MODE == 2 && cx.local && t < cx.nloc) {
                    int gq_pos_t = gq_pos; asm volatile("" : "+v"(gq_pos_t));
                    const int kp0 = cx.gq_kpos0 + t * 64 + hf * 32 - gq_pos_t;
#pragma unroll
                    for (int r = 0; r < 16; ++r) { const int dd = kp0 + crow(r, hi);
                        pp[r] = (dd >= -128 && dd <= 128) ? pp[r] * Cs : -INFINITY; }
                } else {
#pragma unroll
                    for (int r = 0; r < 16; ++r) pp[r] *= Cs;
                }
                float pmax = pp[0];
#pragma unroll
                for (int r = 1; r < 16; ++r) pmax = fmaxf(pmax, pp[r]);
                { auto rr = __builtin_amdgcn_permlane32_swap(__float_as_uint(pmax), __float_as_uint(pmax), false, false);
                  pmax = fmaxf(__uint_as_float(rr[0]), __uint_as_float(rr[1])); }
                float mn = m_reg, alpha = 1.f;
                if (!__all(pmax - m_reg <= THRL2)) { mn = fmaxf(m_reg, pmax); alpha = __builtin_amdgcn_exp2f(m_reg - mn); m_reg = mn; }
#pragma unroll
                for (int r = 0; r < 16; ++r) pp[r] = __builtin_amdgcn_exp2f(pp[r] - mn);
                float ps = 0.f;
#pragma unroll
                for (int r = 0; r < 16; ++r) ps += pp[r];
                { auto rr = __builtin_amdgcn_permlane32_swap(__float_as_uint(ps), __float_as_uint(ps), false, false);
                  ps = __uint_as_float(rr[0]) + __uint_as_float(rr[1]); }
                l_reg = l_reg * alpha + ps;
                bf16x8 pa0, pa1;
#define PK4(P, BASE, OUT) do { unsigned a0 = cvt_pk_bf16(P[BASE + 0], P[BASE + 1]), a1 = cvt_pk_bf16(P[BASE + 2], P[BASE + 3]);   \
    unsigned b0 = cvt_pk_bf16(P[BASE + 4], P[BASE + 5]), b1 = cvt_pk_bf16(P[BASE + 6], P[BASE + 7]);                              \
    auto r0 = __builtin_amdgcn_permlane32_swap(a0, b0, false, false); auto r1 = __builtin_amdgcn_permlane32_swap(a1, b1, false, false); \
    u32x4 w = {r0[0], r1[0], r0[1], r1[1]}; OUT = *reinterpret_cast<bf16x8*>(&w); } while (0)
                PK4(pp, 0, pa0); PK4(pp, 8, pa1);
#undef PK4
                if (__any(alpha < 1.f)) {
                    if (hi == 0) al_l[r32] = alpha;
                    asm volatile("s_waitcnt lgkmcnt(0)" ::: "memory");
#pragma unroll
                    for (int r = 0; r < 16; ++r) { const float a = al_l[crow(r, hi)];
#pragma unroll
                        for (int d = 0; d < NDV; ++d) o[d][r] *= a; }
                }
                asm volatile("s_waitcnt lgkmcnt(0)" ::: "memory"); __builtin_amdgcn_sched_barrier(0);
                if constexpr (NDV == 4) {
                    VFrag vg[2];
                    if (hf == 0) { pv_reads<2, 0>(vg[0], vb); pv_reads<3, 0>(vg[1], vb); } else { pv_reads<2, 1>(vg[0], vb); pv_reads<3, 1>(vg[1], vb); }
                    pv_mma(o[0], vf[0], pa0, pa1); pv_mma(o[1], vf[1], pa0, pa1);
                    asm volatile("s_waitcnt lgkmcnt(0)" ::: "memory"); __builtin_amdgcn_sched_barrier(0);
                    pv_mma(o[2], vg[0], pa0, pa1); pv_mma(o[3], vg[1], pa0, pa1);
                } else { pv_mma(o[0], vf[0], pa0, pa1); pv_mma(o[1], vf[1], pa0, pa1); }
            }
        }
        if (t + 1 < nt) AT_WRITE(buf ^ 1);
        __syncthreads();
    }
    if (MODE == 2) { const float sk = cx.sink[wq] * LOG2E; l_reg += __builtin_amdgcn_exp2f(sk - m_reg); }
    if (hi == 0) li_l[r32] = l_reg;
    asm volatile("s_waitcnt lgkmcnt(0)" ::: "memory");
    if (cx.Ob8) {
        unsigned char* Ow = cx.Ob8 + (wid >> 1) * cx.owoff + r32;
#pragma unroll
        for (int r = 0; r < 16; ++r) { const int j = crow(r, hi); const float rl = __builtin_amdgcn_rcpf(li_l[j]) * 16.0f;
            unsigned char* op = Ow + (size_t)attn_qtok(cx, wid, j) * cx.ldo;
            if constexpr (NDV == 4) { const unsigned w = pk4_fp8(o[0][r] * rl, o[1][r] * rl, o[2][r] * rl, o[3][r] * rl);
                op[0] = (unsigned char)(w & 0xffu); op[32] = (unsigned char)((w >> 8) & 0xffu); op[64] = (unsigned char)((w >> 16) & 0xffu); op[96] = (unsigned char)(w >> 24); }
            else { const unsigned w = pk4_fp8(o[0][r] * rl, o[1][r] * rl, 0.f, 0.f); op[0] = (unsigned char)(w & 0xffu); op[32] = (unsigned char)((w >> 8) & 0xffu); } }
    } else {
    bf16_t* Ow = cx.Ob + (wid >> 1) * cx.owoff + r32;
#pragma unroll
    for (int r = 0; r < 16; ++r) { const int j = crow(r, hi); const float rl = __builtin_amdgcn_rcpf(li_l[j]);
        bf16_t* op = Ow + (size_t)attn_qtok(cx, wid, j) * cx.ldo;
#pragma unroll
        for (int d = 0; d < NDV; ++d) { const unsigned w = cvt_pk_bf16(o[d][r] * rl, 0.f); op[d * 32] = (bf16_t)(w & 0xffffu); } }
    }
    __syncthreads();
#undef AT_TOK
#undef AT_LOAD
#undef AT_WRITE
}

constexpr int CVT_LDS_OFF = 40960, CVT_LDS_WAVE = 64 * 144;
__device__ __forceinline__ void cvt_task(const Frame& F, const float* src, size_t ldsrc, int sc0, int k0, bf16_t* dst, int ldd, int dcol0, int dmode, int dbase, const float* rowgain) {
    const int lane = F.lane;
    LAS unsigned char* T = F.lds + CVT_LDS_OFF + F.wave * CVT_LDS_WAVE;
    if (sc0 >= 0) {
        const float* sp = src + (size_t)(k0 + 16 * (lane >> 4)) * ldsrc + sc0 + 4 * (lane & 15);
        f32x4 v[16];
#pragma unroll
        for (int u = 0; u < 16; ++u) v[u] = __builtin_nontemporal_load((const f32x4*)(sp + (size_t)u * ldsrc));
        if (rowgain) {
#pragma unroll
            for (int u = 0; u < 16; ++u) v[u] *= rowgain[k0 + 16 * (lane >> 4) + u]; }
#pragma unroll
        for (int j = 0; j < 4; ++j) { u32x4 w0, w1;
            w0.x = cvt_pk_bf16(v[0][j], v[1][j]); w0.y = cvt_pk_bf16(v[2][j], v[3][j]); w0.z = cvt_pk_bf16(v[4][j], v[5][j]); w0.w = cvt_pk_bf16(v[6][j], v[7][j]);
            w1.x = cvt_pk_bf16(v[8][j], v[9][j]); w1.y = cvt_pk_bf16(v[10][j], v[11][j]); w1.z = cvt_pk_bf16(v[12][j], v[13][j]); w1.w = cvt_pk_bf16(v[14][j], v[15][j]);
            LAS unsigned char* tp = T + (4 * (lane & 15) + j) * 144 + (lane >> 4) * 32;
            *(LAS u32x4*)tp = w0; *(LAS u32x4*)(tp + 16) = w1; }
    }
    asm volatile("s_waitcnt lgkmcnt(0)" ::: "memory");
#pragma unroll
    for (int i = 0; i < 8; ++i) { const int c = i * 64 + lane, n = c >> 3, ch = c & 7;
        u32x4 w = {0u, 0u, 0u, 0u}; if (sc0 >= 0) w = *(const LAS u32x4*)(T + n * 144 + ch * 16);
        const int hn = dbase + n; const size_t drow = dmode == 0 ? (size_t)hn : (size_t)((hn >> 7) * 256 + (hn & 127));
        *(u32x4*)(dst + drow * (size_t)ldd + dcol0 + k0 + ch * 8) = w; }
    asm volatile("s_waitcnt lgkmcnt(0)" ::: "memory");
}
__device__ __forceinline__ void cvt_task8(const Frame& F, const float* src, size_t ldsrc, int sc0, int k0, unsigned char* dst, int ldd, int dmode, int dbase, float wscale, const float* rowgain = nullptr) {
    const int lane = F.lane;
    LAS unsigned char* T = F.lds + CVT_LDS_OFF + F.wave * CVT_LDS_WAVE;
    const float* sp = src + (size_t)(k0 + 16 * (lane >> 4)) * ldsrc + sc0 + 4 * (lane & 15);
    f32x4 v[16];
#pragma unroll
    for (int u = 0; u < 16; ++u) v[u] = __builtin_nontemporal_load((const f32x4*)(sp + (size_t)u * ldsrc));
    if (rowgain) {
#pragma unroll
        for (int u = 0; u < 16; ++u) v[u] *= rowgain[k0 + 16 * (lane >> 4) + u]; }
#pragma unroll
    for (int j = 0; j < 4; ++j) { u32x4 w;
        w.x = pk4_fp8(v[0][j] * wscale, v[1][j] * wscale, v[2][j] * wscale, v[3][j] * wscale); w.y = pk4_fp8(v[4][j] * wscale, v[5][j] * wscale, v[6][j] * wscale, v[7][j] * wscale);
        w.z = pk4_fp8(v[8][j] * wscale, v[9][j] * wscale, v[10][j] * wscale, v[11][j] * wscale); w.w = pk4_fp8(v[12][j] * wscale, v[13][j] * wscale, v[14][j] * wscale, v[15][j] * wscale);
        *(LAS u32x4*)(T + (4 * (lane & 15) + j) * 80 + (lane >> 4) * 16) = w; }
    asm volatile("s_waitcnt lgkmcnt(0)" ::: "memory");
#pragma unroll
    for (int i = 0; i < 4; ++i) { const int c = i * 64 + lane, n = c >> 2, ch = c & 3;
        const u32x4 w = *(const LAS u32x4*)(T + n * 80 + ch * 16);
        const int hn = dbase + n; const size_t drow = dmode == 0 ? (size_t)hn : (size_t)((hn >> 7) * 256 + (hn & 127));
        *(u32x4*)(dst + drow * (size_t)ldd + k0 + ch * 16) = w; }
    asm volatile("s_waitcnt lgkmcnt(0)" ::: "memory");
}
constexpr int CVT_DENSE = 7360, CVT_EXP = 768, CVT_LAYER = CVT_DENSE + CVT_EXP * NEXP;
__device__ __forceinline__ void cvt_do(const Frame& F, const int t) {
        const int l = t / CVT_LAYER; int r = t % CVT_LAYER;
        const float* src; bf16_t* dst; const float* rowgain = nullptr; int K, N, cb, kc, sc0, ldd = 0, dcol0 = 0, dmode = 0, dbase = 0; bool is_wout = false, is_wo = false; int wup_row0 = -1;
        if (r < CVT_DENSE) {
            if (r < 4864) { K = 2048; N = IN_COLS; src = inp(F, I_WIN) + (size_t)l * DM * IN_COLS; dst = (bf16_t*)(F.ws + WS_WIN + l * SZ_WIN); }
            else if (r < 5056) { r -= 4864; K = 512; N = 1536; src = inp(F, I_WUQ) + (size_t)l * 512 * 1536; dst = (bf16_t*)(F.ws + WS_WUP + l * SZ_WUP); rowgain = inp(F, I_MQNG) + l * 512; wup_row0 = 0; }
            else if (r < 5312) { r -= 5056; K = 512; N = 2048; src = inp(F, I_WUKV) + (size_t)l * 512 * 2048; dst = (bf16_t*)(F.ws + WS_WUP + l * SZ_WUP) + (size_t)1536 * 512; rowgain = inp(F, I_MKVNG) + l * 512; wup_row0 = 1536; }
            else if (r < 5824) { r -= 5312; K = 1024; N = 2048; src = inp(F, I_WOM) + (size_t)l * 1024 * 2048; dst = (bf16_t*)(F.ws + WS_WOC + l * SZ_WOC); ldd = 2048; dcol0 = 0; is_wo = true; }
            else if (r < 6080) { r -= 5824; K = 512; N = 2048; src = inp(F, I_WON) + (size_t)l * 512 * 2048; dst = (bf16_t*)(F.ws + WS_WOC + l * SZ_WOC); ldd = 2048; dcol0 = 1024; is_wo = true; }
            else if (r < 6336) { r -= 6080; K = 512; N = 2048; src = inp(F, I_WOG) + (size_t)l * 512 * 2048; dst = (bf16_t*)(F.ws + WS_WOC + l * SZ_WOC); ldd = 2048; dcol0 = 1536; is_wo = true; }
            else { r -= 6336; K = 2048; N = 2048; src = inp(F, I_WOUT) + (size_t)l * 2048 * 2048; dst = (bf16_t*)(F.ws + WS_WOUT + l * SZ_WOUT); is_wout = true; }
            const int nkc = K >> 6; cb = r / nkc; kc = r % nkc; sc0 = cb * 64; dbase = cb * 64;
            if (K == 2048 && N == IN_COLS) { const int n0 = cb * 64; sc0 = n0 < 1024 ? n0 : (n0 < P_KR ? n0 + 64 : (n0 < P_KR + 64 ? n0 - P_KR + 1024 : -1));
                if (n0 < P_KR) {
                    cvt_task8(F, src, (size_t)IN_COLS, sc0, kc * 64, (unsigned char*)(F.ws + WS_WIN8 + l * SZ_WIN8), 2048, 0, n0, 64.0f); return; } }
        } else {
            r -= CVT_DENSE;
            const bool isdn = r >= 512 * NEXP; const int e = isdn ? (r - 512 * NEXP) >> 8 : r >> 9, kind = isdn ? 2 : (r >> 8) & 1, q = r & 255;
            if (kind < 2) { unsigned char* d8 = (unsigned char*)(F.ws + WS_WGU + l * SZ_WGU) + ((size_t)e * 1024 + kind * 128) * 2048;
                cvt_task8(F, inp(F, kind ? I_WU : I_WG) + ((size_t)l * NEXP + e) * DM * MOE_H, (size_t)MOE_H, (q >> 5) * 64, (q & 31) * 64, d8, 2048, 1, (q >> 5) * 64, 64.0f);
                return; }
            else { unsigned char* d8 = (unsigned char*)(F.ws + WS_WD + l * SZ_WD) + (size_t)e * 2048 * 512;
                cvt_task8(F, inp(F, I_WDN) + ((size_t)l * NEXP + e) * MOE_H * DM, (size_t)DM, (q >> 3) * 64, (q & 7) * 64, d8, 512, 0, (q >> 3) * 64, 32.0f);
                return; }
        }
        if (wup_row0 >= 0) { cvt_task8(F, src, (size_t)N, sc0, kc * 64, (unsigned char*)(F.ws + WS_WUP + l * SZ_WUP), 512, 0, wup_row0 + dbase, 64.0f, rowgain); return; }
        if (is_wout) { cvt_task8(F, src, (size_t)N, sc0, kc * 64, (unsigned char*)(F.ws + WS_WOUT8 + l * SZ_WOUT8), 2048, 0, dbase, 64.0f);
            if (l != 0) return; }
        if (is_wo) { cvt_task8(F, src, (size_t)N, sc0, kc * 64, (unsigned char*)(F.ws + WS_WOC8 + l * SZ_WOC8) + dcol0, 2048, 0, dbase, 64.0f);
            if (l != 0) return; }
        cvt_task(F, src, (size_t)N, sc0, kc * 64, dst, ldd ? ldd : K, dcol0, dmode, dbase, rowgain);
}
constexpr int CVT_Q_MOE0 = CVT_EXP * NEXP, CVT_Q_L1D = CVT_Q_MOE0 + CVT_DENSE, CVT_Q_ALL = CVT_Q_MOE0 + CVT_LAYER;
constexpr int BG_PER_WAVE = 10;
constexpr int BG_M1 = 12, BG_M1_BLK0 = 176, BG_M1_TASKS = (256 - BG_M1_BLK0) * 8 * BG_M1;
constexpr int BG_M1B = 5, BG_M1B_BLK0 = 112, BG_M1B_TASKS = (256 - BG_M1B_BLK0) * 8 * BG_M1B;
__device__ __forceinline__ void bg_range(const Frame& F, const int qa, const int qb) {
#pragma unroll 1
    for (int q = qa + F.gw; q < qb; q += F.nwt) cvt_do(F, q < CVT_Q_MOE0 ? CVT_DENSE + q : CVT_LAYER + (q - CVT_Q_MOE0));
}
__device__ __forceinline__ void bg_idle(const Frame& F, const int qa, const int idle_rank, const int per_wave = BG_PER_WAVE) {
#pragma unroll 1
    for (int n = 0; n < per_wave; ++n) { const int q = qa + (idle_rank * 8 + F.wave) * per_wave + n; cvt_do(F, q < CVT_Q_MOE0 ? CVT_DENSE + q : CVT_LAYER + (q - CVT_Q_MOE0)); }
}
__device__ __forceinline__ void phase0(const Frame& F0) {
    const Frame F = refresh(F0);
    float* sv = (float*)F.ldsg;
    float* red = (float*)(F.ldsg + 32768);
    { const float* cc = inp(F, I_C); const float* cx_ = inp(F, I_CCTX);
      for (int i = F.tid; i < 3 * DM; i += 512) { const int v = i / DM, k = i % DM; const float c = v < 2 ? cc[v * DM + k] : cx_[k]; sv[i] = siluf_(c); } }
    __syncthreads();
    float* mod = (float*)(F.ws + WS_MOD); const float* adaw = inp(F, I_ADAW); const float* adab = inp(F, I_ADAB);
    for (int task = F.bid; task < 768; task += F.G) {
        const int l = task / 384, n0 = (task % 384) * 32, col = n0 + (F.lane & 31), kpar = F.lane >> 5, kbase = F.wave * 256;
        const float* W = adaw + (size_t)l * DM * 6 * DM + col;
        float a0 = 0.f, a1 = 0.f, a2 = 0.f;
#pragma unroll 1
        for (int kk = 0; kk < 128; kk += 16) {
            float w[16];
#pragma unroll
            for (int u = 0; u < 16; ++u) w[u] = __builtin_nontemporal_load(W + (size_t)(kbase + (kk + u) * 2 + kpar) * (6 * DM));
#pragma unroll
            for (int u = 0; u < 16; ++u) { const int k = kbase + (kk + u) * 2 + kpar; a0 = fmaf(w[u], sv[k], a0); a1 = fmaf(w[u], sv[DM + k], a1); a2 = fmaf(w[u], sv[2 * DM + k], a2); }
        }
        const int slot = F.wave * 2 + kpar;
        red[(0 * 16 + slot) * 32 + (F.lane & 31)] = a0; red[(1 * 16 + slot) * 32 + (F.lane & 31)] = a1; red[(2 * 16 + slot) * 32 + (F.lane & 31)] = a2;
        __syncthreads();
        if (F.tid < 96) { const int v = F.tid / 32, c = F.tid % 32; float s = 0.f;
#pragma unroll
            for (int j = 0; j < 16; ++j) s += red[(v * 16 + j) * 32 + c];
            mod[(size_t)(l * 3 + v) * 6 * DM + n0 + c] = s + adab[l * 6 * DM + n0 + c]; }
        __syncthreads();
    }
    { float2* rope = (float2*)(F.ws + WS_ROPE);
      for (int idx = F.bid * 512 + F.tid; idx < SEQ * 32; idx += F.G * 512) { const int pos = idx >> 5, i = idx & 31, j = i & 15;
          const float inv = powf(10000.0f, -(float)j / 16.0f); const float a = (i < 16 ? (float)(pos >> 6) : (float)(pos & 63)) * inv;
          float s, c; sincosf(a, &s, &c); rope[idx] = make_float2(c, s); } }
    { bf16_t* wr = (bf16_t*)(F.ws + WS_WR); const float* wgrp = inp(F, I_WGRP); const float* wexp = inp(F, I_WEXP);
      for (int idx = F.bid * 512 + F.tid; idx < NLAYER * 48 * DM; idx += F.G * 512) { const int l = idx / (48 * DM), rem = idx % (48 * DM), n = rem / DM, k = rem % DM;
          float v = 0.f; if (n < 4) v = wgrp[((size_t)l * DM + k) * 4 + n]; else if (n < 36) v = wexp[((size_t)l * DM + k) * 32 + (n - 4)];
          wr[idx] = (bf16_t)(cvt_pk_bf16(v, 0.f) & 0xffffu); } }
#pragma unroll 1
    for (int t = F.gw; t < CVT_DENSE; t += F.nwt) cvt_do(F, t);
}

__device__ __forceinline__ void norm_mod_store(const f32x4 (&xv)[8], const float* g, const float* sh, const float* sc, bf16_t* hrow, int lane, unsigned char* h8row = nullptr) {
    float ss = 0.f;
#pragma unroll
    for (int i = 0; i < 8; ++i) ss += xv[i][0] * xv[i][0] + xv[i][1] * xv[i][1] + xv[i][2] * xv[i][2] + xv[i][3] * xv[i][3];
    ss = wave_sum(ss);
    const float r = rsqrtf(ss * (1.0f / DM) + EPS);
#pragma unroll
    for (int i = 0; i < 8; ++i) { const int c = i * 256 + lane * 4;
        const f32x4 gv = *(const f32x4*)(g + c), shv = *(const f32x4*)(sh + c), scv = *(const f32x4*)(sc + c);
        f32x4 h;
#pragma unroll
        for (int j = 0; j < 4; ++j) h[j] = (xv[i][j] * r * gv[j]) * (1.0f + scv[j]) + shv[j];
        u32x2 w; w.x = cvt_pk_bf16(h[0], h[1]); w.y = cvt_pk_bf16(h[2], h[3]); *(u32x2*)(hrow + c) = w;
        if (h8row) *(unsigned*)(h8row + c) = pk4_fp8(h[0], h[1], h[2], h[3]); }
}
constexpr int NTAB_OFF = 65536;
__device__ __forceinline__ LAS float* norm_tables(const Frame& F, const float* g, int l, int ch_sh, int ch_sc) {
    LAS float* tab = (LAS float*)(F.lds + NTAB_OFF);
    const float* ml = (const float*)(F.ws + WS_MOD) + (size_t)l * 3 * 6 * DM;
    __syncthreads();
    for (int i = F.tid; i < 3 * DM / 4; i += 512) { const int v = i / (DM / 4), c = (i % (DM / 4)) * 4;
        const f32x4 gv = *(const f32x4*)(g + c), shv = *(const f32x4*)(ml + (size_t)(v * 6 + ch_sh) * DM + c), scv = *(const f32x4*)(ml + (size_t)(v * 6 + ch_sc) * DM + c);
        *(LAS f32x4*)(tab + v * DM + c) = gv * (1.0f + scv); *(LAS f32x4*)(tab + 3 * DM + v * DM + c) = shv; }
    __syncthreads();
    return tab;
}
__device__ __forceinline__ void norm_mod_store_t(const f32x4 (&xv)[8], const LAS float* tab, int row, bf16_t* hrow, int lane, unsigned char* h8row) {
    const int v = row < TL ? (row >> 12) : 2; const LAS float* gs = tab + v * DM; const LAS float* sh = tab + 3 * DM + v * DM;
    float ss = 0.f;
#pragma unroll
    for (int i = 0; i < 8; ++i) ss += xv[i][0] * xv[i][0] + xv[i][1] * xv[i][1] + xv[i][2] * xv[i][2] + xv[i][3] * xv[i][3];
    ss = wave_sum(ss);
    const float r = rsqrtf(ss * (1.0f / DM) + EPS);
#pragma unroll
    for (int i = 0; i < 8; ++i) { const int c = i * 256 + lane * 4;
        const f32x4 gv = *(const LAS f32x4*)(gs + c), shv = *(const LAS f32x4*)(sh + c);
        f32x4 h;
#pragma unroll
        for (int j = 0; j < 4; ++j) h[j] = (xv[i][j] * r) * gv[j] + shv[j];
        u32x2 w; w.x = cvt_pk_bf16(h[0], h[1]); w.y = cvt_pk_bf16(h[2], h[3]); *(u32x2*)(hrow + c) = w;
        *(unsigned*)(h8row + c) = pk4_fp8(h[0], h[1], h[2], h[3]); }
}
__device__ __forceinline__ const float* mod_ptr(const Frame& F, int l, int row, int chunk) {
    const int v = row < TL ? (row >> 12) : 2;
    return (const float*)(F.ws + WS_MOD) + ((size_t)(l * 3 + v) * 6 + chunk) * DM;
}
__device__ __forceinline__ void phase_norm(const Frame& F0, int l, int which, int nrows) {
    const Frame F = refresh(F0);
    bf16_t* hb = (bf16_t*)(F.ws + WS_HBUF);
    const float* g = inp(F, which ? I_NFFNG : I_NMIXG) + l * DM;
    const float* xin = inp(F, I_X); const float* cin = inp(F, I_CTX);
    const LAS float* tab = norm_tables(F, g, l, which ? 3 : 0, which ? 4 : 1);
    for (int row = F.gw; row < nrows; row += F.nwt) {
        const float* xr = row < TL ? xin + (size_t)row * DM : cin + (size_t)(row - TL) * DM;
        f32x4 xv[8];
#pragma unroll
        for (int i = 0; i < 8; ++i) xv[i] = *(const f32x4*)(xr + i * 256 + F.lane * 4);
        norm_mod_store_t(xv, tab, row, hb + (size_t)row * DM, F.lane, (unsigned char*)(F.ws + WS_HB8) + (size_t)row * DM);
    }
}

__device__ __forceinline__ void unpack8(const u32x4 w, float (&f)[8]) { f[0] = bf_lo(w.x); f[1] = bf_hi(w.x); f[2] = bf_lo(w.y); f[3] = bf_hi(w.y); f[4] = bf_lo(w.z); f[5] = bf_hi(w.z); f[6] = bf_lo(w.w); f[7] = bf_hi(w.w); }
__device__ __forceinline__ u32x4 pack8(const float (&f)[8]) { u32x4 w; w.x = cvt_pk_bf16(f[0], f[1]); w.y = cvt_pk_bf16(f[2], f[3]); w.z = cvt_pk_bf16(f[4], f[5]); w.w = cvt_pk_bf16(f[6], f[7]); return w; }
template <int GS> __device__ __forceinline__ float group_sum(float v) {
#pragma unroll
    for (int o = GS / 2; o > 0; o >>= 1) v += __shfl_xor(v, o);
    return v;
}
__device__ __forceinline__ void rope8(float (&f)[8], const float2* cs, int lane) {
    const int ch = lane & 7; const bool lo = ch < 4; const int i0 = (ch & 3) * 8;
#pragma unroll
    for (int e = 0; e < 8; ++e) { const float other = __shfl_xor(f[e], 4); const float2 c = cs[i0 + e];
        f[e] = lo ? (f[e] * c.x - other * c.y) : (other * c.y + f[e] * c.x); }
}
template <int NT>
__device__ __forceinline__ void small_rows_mma(const bf16_t* A, int lda, const bf16_t* Bt, int row0, int kq, int lane, f32x4 (&acc)[NT]) {
    const bf16_t* ap = A + (size_t)(row0 + (lane & 15)) * lda + kq * 512 + (lane >> 4) * 8;
    const bf16_t* bp = Bt + (size_t)(lane & 15) * DM + kq * 512 + (lane >> 4) * 8;
#pragma unroll
    for (int n = 0; n < NT; ++n) acc[n] = (f32x4){0.f, 0.f, 0.f, 0.f};
#pragma unroll 8
    for (int ks = 0; ks < 16; ++ks) {
        const bf16x8 a = *(const bf16x8*)(ap + ks * 32);
#pragma unroll
        for (int n = 0; n < NT; ++n) { const bf16x8 bb = *(const bf16x8*)(bp + (size_t)n * 16 * DM + ks * 32); acc[n] = __builtin_amdgcn_mfma_f32_16x16x32_bf16(a, bb, acc[n], 0, 0, 0); }
    }
}
template <int NT>
__device__ __forceinline__ void small_rows_mma8(const bf16_t* A, int lda, const bf16_t* Bt, int row0, int k8, int lane, f32x4 (&acc)[2][NT]) {
    const bf16_t* ap = A + (size_t)(row0 + (lane & 15)) * lda + k8 * 256 + (lane >> 4) * 8;
    const bf16_t* bp = Bt + (size_t)(lane & 15) * DM + k8 * 256 + (lane >> 4) * 8;
    bf16x8 a[2][8], b[NT][8];
#pragma unroll
    for (int ks = 0; ks < 8; ++ks) { a[0][ks] = *(const bf16x8*)(ap + ks * 32); a[1][ks] = *(const bf16x8*)(ap + (size_t)16 * lda + ks * 32); }
#pragma unroll
    for (int n = 0; n < NT; ++n)
#pragma unroll
        for (int ks = 0; ks < 8; ++ks) b[n][ks] = *(const bf16x8*)(bp + (size_t)n * 16 * DM + ks * 32);
#pragma unroll
    for (int g = 0; g < 2; ++g)
#pragma unroll
        for (int n = 0; n < NT; ++n) acc[g][n] = (f32x4){0.f, 0.f, 0.f, 0.f};
#pragma unroll
    for (int ks = 0; ks < 8; ++ks)
#pragma unroll
        for (int g = 0; g < 2; ++g)
#pragma unroll
            for (int n = 0; n < NT; ++n) acc[g][n] = __builtin_amdgcn_mfma_f32_16x16x32_bf16(a[g][ks], b[n][ks], acc[g][n], 0, 0, 0);
}
template <int NT>
__device__ __forceinline__ void small_rows_part(float* part, int k8, int lane, const f32x4 (&acc)[2][NT]) {
    float* pp = part + k8 * (32 * NT * 16);
#pragma unroll
    for (int g = 0; g < 2; ++g)
#pragma unroll
        for (int n = 0; n < NT; ++n)
#pragma unroll
            for (int r = 0; r < 4; ++r) pp[(g * 16 + 4 * (lane >> 4) + r) * (NT * 16) + n * 16 + (lane & 15)] = acc[g][n][r];
}
struct Prep1G { const float *mq, *mkv, *naq, *nak, *gq, *gk; };
__device__ __forceinline__ void prep1_row(bf16_t* pr, const u32x4 (&sg)[6], const Prep1G& G, bool lat, const float2* cs, int lane, bool wr_ = true) {
    float f[8];
#pragma unroll
    for (int w = 0; w < 2; ++w) { const float* g = w ? G.nak : G.naq;
        unpack8(sg[2 + w], f); float ss = 0.f;
#pragma unroll
        for (int e = 0; e < 8; ++e) ss += f[e] * f[e];
        ss = group_sum<16>(ss); const float r = rsqrtf(ss * (1.0f / 128) + EPS);
#pragma unroll
        for (int e = 0; e < 8; ++e) f[e] = f[e] * r * g[e];
        if (wr_) *(u32x4*)(pr + (w ? P_NAK : P_NAQ) + lane * 8) = pack8(f); }
    { unpack8(sg[4], f); float ss = 0.f;
#pragma unroll
      for (int e = 0; e < 8; ++e) ss += f[e] * f[e];
      ss = group_sum<8>(ss); const float r = rsqrtf(ss * (1.0f / 64) + EPS);
#pragma unroll
      for (int e = 0; e < 8; ++e) f[e] = f[e] * r * G.gq[e];
      if (lat) rope8(f, cs, lane);
      if (wr_) *(u32x4*)(pr + P_GQ + lane * 8) = pack8(f); }
    { unpack8(sg[5], f); float ss = 0.f;
#pragma unroll
      for (int e = 0; e < 8; ++e) ss += f[e] * f[e];
      ss = group_sum<8>(ss); const float r = rsqrtf(ss * (1.0f / 64) + EPS);
#pragma unroll
      for (int e = 0; e < 8; ++e) f[e] = f[e] * r * G.gk[e];
      if (lat) rope8(f, cs, lane);
      if (wr_ && lane < 16) *(u32x4*)(pr + P_GK + (lane & 15) * 8) = pack8(f); }
}
__device__ __forceinline__ void phase_prep1(const Frame& F0, int l, int dry = 0) {
    const Frame F = refresh(F0);
    bf16_t* proj = (bf16_t*)(F.ws + WS_PROJ); const float2* rope = (const float2*)(F.ws + WS_ROPE);
    const int lane = F.lane;
    { const bf16_t* hb = (const bf16_t*)(F.ws + WS_HBUF); const bf16_t* wk = (const bf16_t*)(F.ws + WS_WIN + l * SZ_WIN) + (size_t)P_KR * DM;
      float* part = (float*)F.ldsg;
      for (int task = F.bid; task < TT / 32; task += F.G) {
          const int row0 = task * 32; f32x4 acc[2][4];
          small_rows_mma8<4>(hb, DM, wk, row0, F.wave, lane, acc);
          small_rows_part<4>(part, F.wave, lane, acc);
          __syncthreads();
          { const int rr = F.tid >> 4, c4 = (F.tid & 15) * 4; const float* q = part + rr * 64 + c4; f32x4 v = *(const f32x4*)q;
#pragma unroll
            for (int k = 1; k < 8; ++k) v += *(const f32x4*)(q + k * 2048);
            u32x2 w; w.x = cvt_pk_bf16(v[0], v[1]); w.y = cvt_pk_bf16(v[2], v[3]);
            *(u32x2*)(proj + (size_t)(row0 + rr) * PROJ_LD + P_KR + c4) = w; }
          __syncthreads();
      } }
    Prep1G G; G.mq = inp(F, I_MQNG) + l * 512 + lane * 8; G.mkv = inp(F, I_MKVNG) + l * 512 + lane * 8;
    G.naq = inp(F, I_NAQN) + l * 128 + (lane & 15) * 8; G.nak = inp(F, I_NAKN) + l * 128 + (lane & 15) * 8;
    G.gq = inp(F, I_GQN) + l * 64 + (lane & 7) * 8; G.gk = inp(F, I_GKN) + l * 64 + (lane & 7) * 8;
    constexpr int NR = 5;
    for (int row = F.gw; row < TT; row += NR * F.nwt) {
        u32x4 sg[NR][6];
#pragma unroll
        for (int j = 0; j < NR; ++j) { const int rj = row + j * F.nwt < TT ? row + j * F.nwt : row; const bf16_t* pr = proj + (size_t)rj * PROJ_LD;
            sg[j][0] = (u32x4){0u, 0u, 0u, 0u}; sg[j][1] = sg[j][0]; sg[j][2] = *(const u32x4*)(pr + P_NAQ + lane * 8);
            sg[j][3] = *(const u32x4*)(pr + P_NAK + lane * 8); sg[j][4] = *(const u32x4*)(pr + P_GQ + lane * 8); sg[j][5] = *(const u32x4*)(pr + P_GK + (lane & 15) * 8); }
#pragma unroll
        for (int j = 0; j < NR; ++j) { const int rj = row + j * F.nwt;
            if (rj < TT) prep1_row(proj + (size_t)rj * PROJ_LD, sg[j], G, rj < TL, rope + (size_t)(rj & (SEQ - 1)) * 32, lane, !dry); }
    }
}

template <class Fin>
__device__ __forceinline__ void small_gemm_rows(const Frame& F, const bf16_t* A, int lda, const bf16_t* Bt, int row_begin, int nrows, int ncols, const Fin& fin) {
    float* part = (float*)F.ldsg;
    const int lane = F.lane, ncb = ncols >> 6;
    for (int task = F.bid; task < (nrows >> 5) * ncb; task += F.G) {
        const int rb = task / ncb, cbk = task - rb * ncb, row0 = row_begin + rb * 32, col0 = cbk * 64;
        f32x4 acc[2][4];
        small_rows_mma8<4>(A, lda, Bt + (size_t)col0 * DM, row0, F.wave, lane, acc);
        small_rows_part<4>(part, F.wave, lane, acc);
        __syncthreads();
        { const int rr = F.tid >> 4, c4 = (F.tid & 15) * 4; const float* q = part + rr * 64 + c4;
          fin(row0 + rr, col0 + c4, *(const f32x4*)q + *(const f32x4*)(q + 2048), *(const f32x4*)(q + 2 * 2048) + *(const f32x4*)(q + 3 * 2048),
              *(const f32x4*)(q + 4 * 2048) + *(const f32x4*)(q + 5 * 2048), *(const f32x4*)(q + 6 * 2048) + *(const f32x4*)(q + 7 * 2048)); }
        __syncthreads();
    }
}

__device__ __forceinline__ void prep2_row(bf16_t* q, unsigned char* k, const u32x4 (&sg)[6], const float* gq, const float* gk, bool lat, const float2* cs, int lane, bool wr_ = true) {
    const int ch = lane & 7;
    float f0[8], f1[8], f2[8];
    { unpack8(sg[3], f0); unpack8(sg[4], f1); unpack8(sg[5], f2);
      float ss = 0.f;
#pragma unroll
      for (int e = 0; e < 8; ++e) ss += f0[e] * f0[e] + f1[e] * f1[e] + f2[e] * f2[e];
      ss = group_sum<8>(ss); const float r = rsqrtf(ss * (1.0f / 192) + EPS);
#pragma unroll
      for (int e = 0; e < 8; ++e) { f0[e] *= r * gk[ch * 8 + e]; f1[e] *= r * gk[64 + ch * 8 + e]; f2[e] *= r * gk[128 + ch * 8 + e]; }
      if (lat) rope8(f2, cs, lane);
      if (wr_) {
          u32x2 w; w.x = pk4_fp8(f0[0], f0[1], f0[2], f0[3]); w.y = pk4_fp8(f0[4], f0[5], f0[6], f0[7]); *(u32x2*)(k) = w;
          w.x = pk4_fp8(f1[0], f1[1], f1[2], f1[3]); w.y = pk4_fp8(f1[4], f1[5], f1[6], f1[7]); *(u32x2*)(k + 64) = w;
          w.x = pk4_fp8(f2[0], f2[1], f2[2], f2[3]); w.y = pk4_fp8(f2[4], f2[5], f2[6], f2[7]); *(u32x2*)(k + 128) = w; } }
}
__device__ __forceinline__ void phase_prep2(const Frame& F0, int l, int dry = 0) {
    const Frame F = refresh(F0);
    const int lane = F.lane, h = lane >> 3, ch = lane & 7;
    bf16_t* qraw = (bf16_t*)(F.ws + WS_QRAW); const bf16_t* kvraw = (const bf16_t*)(F.ws + WS_KVRAW); unsigned char* km = (unsigned char*)(F.ws + WS_KM);
    const bf16_t* proj = (const bf16_t*)(F.ws + WS_PROJ); const float2* rope = (const float2*)(F.ws + WS_ROPE);
    const float* gq = inp(F, I_MQN) + l * 192; const float* gk = inp(F, I_MKN) + l * 192;
    constexpr int NR = 5;
    for (int row = F.gw; row < TT; row += NR * F.nwt) {
        u32x4 sg[NR][6];
#pragma unroll
        for (int j = 0; j < NR; ++j) { const int rj = row + j * F.nwt < TT ? row + j * F.nwt : row;
            const bf16_t* q = qraw + (size_t)rj * 1536 + h * 192 + ch * 8; const bf16_t* kv = kvraw + (size_t)rj * 2048 + h * 256 + ch * 8;
            sg[j][0] = (u32x4){0u, 0u, 0u, 0u}; sg[j][1] = sg[j][0]; sg[j][2] = sg[j][0]; (void)q;
            sg[j][3] = *(const u32x4*)(kv); sg[j][4] = *(const u32x4*)(kv + 64); sg[j][5] = *(const u32x4*)(proj + (size_t)rj * PROJ_LD + P_KR + ch * 8); }
#pragma unroll
        for (int j = 0; j < NR; ++j) { const int rj = row + j * F.nwt;
            if (rj < TT) prep2_row(qraw + (size_t)rj * 1536 + h * 192 + ch * 8, km + (size_t)rj * 1536 + h * 192 + ch * 8, sg[j], gq, gk, rj < TL, rope + (size_t)(rj & (SEQ - 1)) * 32, lane, !dry); }
    }
    { LAS unsigned char* T = F.lds + F.wave * 8192; unsigned char* vt8 = (unsigned char*)(F.ws + WS_VT8);
      const int k5 = lane & 31, p = ((k5 >> 2) & 1) * 32 + (lane >> 5) * 16 + (k5 & 3) + 4 * (k5 >> 3);
      for (int task = F.gw; task < (TT / 64) * 8; task += F.nwt) {
          const bf16_t* src = kvraw + (size_t)((task >> 3) * 64 + lane) * 2048 + (task & 7) * 256 + 128;
          u32x4 w[16];
#pragma unroll
          for (int i = 0; i < 16; ++i) w[i] = *(const u32x4*)(src + i * 8);
#pragma unroll
          for (int i = 0; i < 16; ++i) { float f[8]; unpack8(w[i], f); const unsigned a = pk4_fp8(f[0], f[1], f[2], f[3]), b = pk4_fp8(f[4], f[5], f[6], f[7]);
#pragma unroll
              for (int e = 0; e < 4; ++e) { T[(i * 8 + e) * 64 + p] = (unsigned char)((a >> (8 * e)) & 0xffu); T[(i * 8 + 4 + e) * 64 + p] = (unsigned char)((b >> (8 * e)) & 0xffu); } }
          asm volatile("s_waitcnt lgkmcnt(0)" ::: "memory");
          if (!dry) {
#pragma unroll
              for (int c = 0; c < 8; ++c) { const u32x4 v = *(const LAS u32x4*)(T + (c * 64 + lane) * 16); *(u32x4*)(vt8 + (size_t)task * 8192 + (c * 64 + lane) * 16) = v; } }
          asm volatile("s_waitcnt lgkmcnt(0)" ::: "memory");
      } }
}

__device__ __forceinline__ void phase_attn(const Frame& F0, int l) {
    const Frame F = refresh(F0);
    char* lds = F.ldsg;
    const bf16_t* proj = (const bf16_t*)(F.ws + WS_PROJ); const bf16_t* qm = (const bf16_t*)(F.ws + WS_QRAW); const unsigned char* km = (const unsigned char*)(F.ws + WS_KM);
    const bf16_t* kvraw = (const bf16_t*)(F.ws + WS_KVRAW); bf16_t* ocat = (bf16_t*)(F.ws + WS_OCAT);
    unsigned char* ocat8 = (unsigned char*)(F.ws + WS_OCAT);
    const float* mqg = inp(F, I_MQN) + l * 192; const float2* ropet = (const float2*)(F.ws + WS_ROPE);
    const bool ctxq = (l == 0); const float* sinkp = inp(F, I_SINK) + l * 8; const float* rpbp = inp(F, I_RPB) + (size_t)l * 4 * 465;
    const int n_mla = 256 + (ctxq ? 16 : 0);
    for (int rp_ = 0; rp_ < REPS(16); ++rp_)
    for (int it = F.bid; it < n_mla; it += F.G) {
        AttnCx cx{}; int b, h;
        if (it < 256) { const int ix = (it & 7) * 32 + (it >> 3);
            b = ix >> 7; h = (ix >> 4) & 7; const int qb = ix & 15; cx.qtok0 = b * SEQ + qb * 256; cx.nloc = 64; cx.nt = 68; cx.ktok_loc0 = b * SEQ; }
        else { const int j = it - 256; b = j >> 3; h = j & 7; cx.qtok0 = TL + b * CL; cx.nloc = 0; cx.nt = 4; cx.ktok_loc0 = 0; }
        cx.ktok_ctx0 = TL + b * CL; cx.qmap = 0;
        cx.mq_gain = mqg; cx.mq_rope = ropet;
        cx.Qb = qm + h * 192; cx.ldq = 1536; cx.qwoff = 0; cx.Kb = (const bf16_t*)(km + h * 192); cx.ldk = 1536;     cx.Vb = (const bf16_t*)((const unsigned char*)(F.ws + WS_VT8) + h * 8192); cx.ldv = 0;
        cx.Ob = ocat + h * 128; cx.Ob8 = it < 256 ? ocat8 + h * 128 : nullptr; cx.ldo = DM; cx.owoff = 0; cx.scale_l2 = 0.07216878364870322f * LOG2E;
        attn_item<192, 128, 0>(lds, cx, F.wave);
    }
    const int n_gq = 256 + (ctxq ? 16 : 0);
    for (int rp_ = 0; rp_ < REPS(17); ++rp_)
    for (int it = F.bid; it < n_gq; it += F.G) {
        AttnCx cx{}; int b, kvh;
        if (it < 256) { const int ix = (it & 7) * 32 + (it >> 3); b = ix >> 7; kvh = (ix >> 6) & 1; const int pb = ix & 63; const int t0 = pb - 2 < 0 ? 0 : pb - 2, t1 = pb + 2 > 63 ? 63 : pb + 2;
            cx.qtok0 = b * SEQ + pb * 64; cx.nloc = t1 - t0 + 1; cx.nt = cx.nloc + 4; cx.ktok_loc0 = b * SEQ + t0 * 64; cx.gq_pos0 = pb * 64; cx.gq_kpos0 = t0 * 64; cx.local = 1; }
        else { const int j = it - 256; b = j >> 3; kvh = (j >> 2) & 1; const int part = j & 3; cx.qtok0 = TL + b * CL + part * 64; cx.nloc = 0; cx.nt = 4; cx.local = 0; }
        cx.ktok_ctx0 = TL + b * CL; cx.qmap = 2;
        cx.Qb = proj + P_GQ + kvh * 256; cx.ldq = PROJ_LD; cx.qwoff = 64; cx.Kb = proj + P_GK + kvh * 64; cx.ldk = PROJ_LD; cx.Vb = proj + P_GV + kvh * 64; cx.ldv = PROJ_LD;
        cx.Ob = ocat + 1536 + kvh * 256; cx.Ob8 = it < 256 ? ocat8 + 1536 + kvh * 256 : nullptr; cx.ldo = DM; cx.owoff = 64; cx.scale_l2 = 0.125f * LOG2E; cx.sink = sinkp + kvh * 4;
        attn_item<64, 64, 2>(lds, cx, F.wave);
    }
    const int n_na = 128 + (ctxq ? 8 : 0);
    float* biasl = (float*)(lds + 100352);
    for (int rp_ = 0; rp_ < REPS(18); ++rp_)
    for (int it = (F.G - 1 - F.bid); it < n_na; it += F.G) {
        AttnCx cx{}; int b, h;
        if (it < 128) { const int ix = (it & 7) * 16 + (it >> 3); b = ix >> 6; h = (ix >> 4) & 3; const int rg = ix & 15; const int kr0 = min(max(rg * 4 - 4, 0), 56), kr1 = min(max(rg * 4 + 3 - 4, 0), 56) + 7;
            cx.qtok0 = b * SEQ + rg * 256; cx.qmap = 1; cx.nloc = kr1 - kr0 + 1; cx.nt = cx.nloc + 4; cx.ktok_loc0 = b * SEQ + kr0 * 64; cx.na_r0 = rg * 4; cx.na_kr0 = kr0; }
        else { const int j = it - 128; b = j >> 2; h = j & 3; cx.qtok0 = TL + b * CL; cx.qmap = 0; cx.nloc = 0; cx.nt = 4; }
        cx.ktok_ctx0 = TL + b * CL;
        for (int i = F.tid; i < 15 * 31; i += 512) biasl[i] = rpbp[h * 465 + i] * LOG2E;
        cx.bias = biasl;
        cx.Qb = proj + P_NAQ + h * 128; cx.ldq = PROJ_LD; cx.qwoff = 0; cx.Kb = proj + P_NAK + h * 128; cx.ldk = PROJ_LD; cx.Vb = proj + P_NAV + h * 128; cx.ldv = PROJ_LD;
        cx.Ob = ocat + 1024 + h * 128; cx.Ob8 = it < 128 ? ocat8 + 1024 + h * 128 : nullptr; cx.ldo = DM; cx.owoff = 0; cx.scale_l2 = 0.08838834764831845f * LOG2E;
        attn_item<128, 128, 1>(lds, cx, F.wave);
    }
    if ((F.G - 1 - F.bid) >= n_na) bg_idle(F, l == 0 ? 0 : CVT_Q_L1D, F.bid);
}

__device__ __forceinline__ void phase_router(const Frame& F0, int l, int nrows, int dry = 0) {
    const Frame F = refresh(F0);
    const int lane = F.lane, grp = F.wave >> 2, kq = F.wave & 3;
    const bf16_t* hb = (const bf16_t*)(F.ws + WS_HBUF); const bf16_t* wr = (const bf16_t*)(F.ws + WS_WR + l * SZ_WR);
    float* part = (float*)F.ldsg;
    const float* bgrp = inp(F, I_BGRP) + l * 4; const float* bexp = inp(F, I_BEXP) + l * 32;
    unsigned* cnt = (unsigned*)(F.ws + WS_CTL) + CW_CNT + l * 32;
    int* tok_e = (int*)(F.ws + WS_TOK); int* tok_pos = (int*)(F.ws + WS_TOK + SZ_TOK1); float* tok_w = (float*)(F.ws + WS_TOK + 2 * SZ_TOK1); int* rlist = (int*)(F.ws + WS_RLIST);
    for (int task = F.bid; task < nrows / 32; task += F.G) {
        const int row0 = task * 32 + grp * 16; f32x4 acc[3];
        small_rows_mma<3>(hb, DM, wr, row0, kq, lane, acc);
        float* pp = part + (grp * 4 + kq) * 768;
#pragma unroll
        for (int n = 0; n < 3; ++n)
#pragma unroll
            for (int r = 0; r < 4; ++r) pp[(4 * (lane >> 4) + r) * 48 + n * 16 + (lane & 15)] = acc[n][r];
        __syncthreads();
        if (kq == 0 && lane < 16 && !dry) {
            const float* L = part + grp * 3072 + lane * 48; const int tok = row0 + lane;
#define LG(j) (L[(j)] + L[768 + (j)] + L[1536 + (j)] + L[2304 + (j)])
            float gl[4]; int gi = 0; float gmax;
#pragma unroll
            for (int g = 0; g < 4; ++g) gl[g] = LG(g) + bgrp[g];
            gmax = gl[0];
#pragma unroll
            for (int g = 1; g < 4; ++g) if (gl[g] > gmax) { gmax = gl[g]; gi = g; }
            float gs = 0.f;
#pragma unroll
            for (int g = 0; g < 4; ++g) gs += __expf(gl[g] - gmax);
            const float gw = 1.0f / gs;
            float el[8];
#pragma unroll
            for (int j = 0; j < 8; ++j) el[j] = LG(4 + gi * 8 + j) + bexp[gi * 8 + j];
#undef LG
            int i1 = 0; float l1 = el[0];
#pragma unroll
            for (int j = 1; j < 8; ++j) if (el[j] > l1) { l1 = el[j]; i1 = j; }
            int i2 = -1; float l2 = -INFINITY;
#pragma unroll
            for (int j = 0; j < 8; ++j) if (j != i1 && el[j] > l2) { l2 = el[j]; i2 = j; }
            const float e2 = __expf(l2 - l1); const float w1 = gw / (1.0f + e2), w2 = gw * e2 / (1.0f + e2);
            const int e_1 = gi * 8 + i1, e_2 = gi * 8 + i2;
            const unsigned p1 = atomicAdd(&cnt[e_1], 1u), p2 = atomicAdd(&cnt[e_2], 1u);
            tok_e[tok * 2] = e_1; tok_e[tok * 2 + 1] = e_2; tok_pos[tok * 2] = (int)p1; tok_pos[tok * 2 + 1] = (int)p2; tok_w[tok * 2] = w1; tok_w[tok * 2 + 1] = w2;
            rlist[(size_t)e_1 * TT + p1] = tok; rlist[(size_t)e_2 * TT + p2] = tok;
        }
        __syncthreads();
    }
}
__device__ __forceinline__ void phase_n2_router(const Frame& F0, int l, int nrows, int dry = 0) {
    const Frame F = refresh(F0);
    const int lane = F.lane;
    bf16_t* hbw = (bf16_t*)(F.ws + WS_HBUF); const bf16_t* hb = hbw; unsigned char* hb8 = (unsigned char*)(F.ws + WS_HB8); const bf16_t* wr = (const bf16_t*)(F.ws + WS_WR + l * SZ_WR);
    const float* gn = inp(F, I_NFFNG) + l * DM; const bf16_t* xmid = (const bf16_t*)(F.ws + WS_XMID);
    float* part = (float*)F.ldsg;
    const float* bgrp = inp(F, I_BGRP) + l * 4; const float* bexp = inp(F, I_BEXP) + l * 32;
    unsigned* cnt = (unsigned*)(F.ws + WS_CTL) + CW_CNT + l * 32;
    int* tok_e = (int*)(F.ws + WS_TOK); int* tok_pos = (int*)(F.ws + WS_TOK + SZ_TOK1); float* tok_w = (float*)(F.ws + WS_TOK + 2 * SZ_TOK1); int* rlist = (int*)(F.ws + WS_RLIST);
    const LAS float* tab = norm_tables(F, gn, l, 3, 4);
    for (int task = F.bid; task < nrows / 32; task += F.G) {
#pragma unroll 1
        for (int rr = 0; rr < 4; rr += 2) {
            const int r0 = task * 32 + F.wave * 4 + rr, r1 = r0 + 1;
            f32x4 xa[8], xb[8];
#pragma unroll
            for (int i = 0; i < 8; ++i) { const u32x2 a = *(const u32x2*)(xmid + (size_t)r0 * DM + i * 256 + lane * 4), b = *(const u32x2*)(xmid + (size_t)r1 * DM + i * 256 + lane * 4);
                xa[i] = (f32x4){bf_lo(a.x), bf_hi(a.x), bf_lo(a.y), bf_hi(a.y)}; xb[i] = (f32x4){bf_lo(b.x), bf_hi(b.x), bf_lo(b.y), bf_hi(b.y)}; }
            norm_mod_store_t(xa, tab, r0, hbw + (size_t)r0 * DM, lane, hb8 + (size_t)r0 * DM);
            norm_mod_store_t(xb, tab, r1, hbw + (size_t)r1 * DM, lane, hb8 + (size_t)r1 * DM);
        }
        asm volatile("s_waitcnt vmcnt(0)" ::: "memory");
        __syncthreads();
        const int row0 = task * 32; f32x4 acc[2][3];
        small_rows_mma8<3>(hb, DM, wr, row0, F.wave, lane, acc);
        small_rows_part<3>(part, F.wave, lane, acc);
        __syncthreads();
        if (F.tid < 32 && !dry) {
            const float* L = part + F.tid * 48; const int tok = row0 + F.tid;
#define LG(j) (((L[(j)] + L[1536 + (j)]) + (L[2 * 1536 + (j)] + L[3 * 1536 + (j)])) + ((L[4 * 1536 + (j)] + L[5 * 1536 + (j)]) + (L[6 * 1536 + (j)] + L[7 * 1536 + (j)])))
            float gl[4]; int gi = 0; float gmax;
#pragma unroll
            for (int g = 0; g < 4; ++g) gl[g] = LG(g) + bgrp[g];
            gmax = gl[0];
#pragma unroll
            for (int g = 1; g < 4; ++g) if (gl[g] > gmax) { gmax = gl[g]; gi = g; }
            float gs = 0.f;
#pragma unroll
            for (int g = 0; g < 4; ++g) gs += __expf(gl[g] - gmax);
            const float gw = 1.0f / gs;
            float el[8];
#pragma unroll
            for (int j = 0; j < 8; ++j) el[j] = LG(4 + gi * 8 + j) + bexp[gi * 8 + j];
#undef LG
            int i1 = 0; float l1 = el[0];
#pragma unroll
            for (int j = 1; j < 8; ++j) if (el[j] > l1) { l1 = el[j]; i1 = j; }
            int i2 = -1; float l2 = -INFINITY;
#pragma unroll
            for (int j = 0; j < 8; ++j) if (j != i1 && el[j] > l2) { l2 = el[j]; i2 = j; }
            const float e2 = __expf(l2 - l1); const float w1 = gw / (1.0f + e2), w2 = gw * e2 / (1.0f + e2);
            const int e_1 = gi * 8 + i1, e_2 = gi * 8 + i2;
            const unsigned p1 = atomicAdd(&cnt[e_1], 1u), p2 = atomicAdd(&cnt[e_2], 1u);
            tok_e[tok * 2] = e_1; tok_e[tok * 2 + 1] = e_2; tok_pos[tok * 2] = (int)p1; tok_pos[tok * 2 + 1] = (int)p2; tok_w[tok * 2] = w1; tok_w[tok * 2 + 1] = w2;
            rlist[(size_t)e_1 * TT + p1] = tok; rlist[(size_t)e_2 * TT + p2] = tok;
        }
        __syncthreads();
    }
    { const int n_na = 128 + (l == 0 ? 8 : 0), n_idle = F.G - n_na > 0 ? F.G - n_na : 0;
      const int taken = n_idle * 8 * BG_PER_WAVE + ((l == 1 && F.G == 256) ? BG_M1_TASKS : 0);
      bg_range(F, (l == 0 ? 0 : CVT_Q_L1D) + taken, l == 0 ? CVT_Q_MOE0 : CVT_Q_ALL - (F.G == 256 ? BG_M1B_TASKS : 0)); }
    __syncthreads();
    if (F.tid == 0 && !dry) {
        unsigned* done = (unsigned*)(F.ws + WS_CTL) + CW_DONE + l;
        const unsigned ticket = __hip_atomic_fetch_add(done, 1u, __ATOMIC_RELAXED, __HIP_MEMORY_SCOPE_AGENT);
        if (ticket == (unsigned)F.G - 1u) {
            int* tg = (int*)(F.ws + WS_CTL) + CW_TILE + l * 384; int o = 0, nt = 0;
            for (int e = 0; e < NEXP; ++e) { tg[320 + e] = o; const int c = (int)__hip_atomic_load(&cnt[e], __ATOMIC_RELAXED, __HIP_MEMORY_SCOPE_AGENT); const int tl = (c + 255) >> 8;
                for (int j = 0; j < tl; ++j) { tg[nt + j] = e; tg[160 + nt + j] = j; } nt += tl; o += tl * 256; }
            tg[320 + NEXP] = o; tg[128] = nt;
        }
    }
}
__device__ __forceinline__ void phase_combine(const Frame& F0, int l, int nrows) {
    const Frame F = refresh(F0);
    const bf16_t* y2 = (const bf16_t*)(F.ws + WS_Y2S); const bf16_t* xmid = (const bf16_t*)(F.ws + WS_XMID);
    const int* tok_e = (const int*)(F.ws + WS_TOK); const int* tok_pos = (const int*)(F.ws + WS_TOK + SZ_TOK1); const float* tok_w = (const float*)(F.ws + WS_TOK + 2 * SZ_TOK1);
    LAS int* offs = (LAS int*)(F.lds + MISC_OFF + 64);
    __syncthreads(); if (F.tid <= NEXP) offs[F.tid] = ((const int*)(F.ws + WS_CTL) + CW_TILE + l * 384)[320 + F.tid]; __syncthreads();
    bf16_t* hb = (bf16_t*)(F.ws + WS_HBUF); float* outp = (float*)inp(F, 32); const float* g_n1 = inp(F, I_NMIXG) + DM;
    const LAS float* tab = nullptr; if (l == 0) tab = norm_tables(F, g_n1, 1, 0, 1);
    for (int row = F.gw; row < nrows; row += F.nwt) {
        const int d0 = offs[tok_e[row * 2]] + tok_pos[row * 2], d1 = offs[tok_e[row * 2 + 1]] + tok_pos[row * 2 + 1]; const float w0 = tok_w[row * 2], w1 = tok_w[row * 2 + 1];
        const float* g2 = mod_ptr(F, l, row, 5);
        const bf16_t* ya = y2 + (size_t)d0 * DM; const bf16_t* yb = y2 + (size_t)d1 * DM;
        f32x4 xv[8];
#pragma unroll
        for (int i = 0; i < 8; ++i) { const int c = i * 256 + F.lane * 4;
            const u32x2 xw = __builtin_nontemporal_load((const u32x2*)(xmid + (size_t)row * DM + c)); const f32x4 x = {bf_lo(xw.x), bf_hi(xw.x), bf_lo(xw.y), bf_hi(xw.y)}; const f32x4 g = *(const f32x4*)(g2 + c);
            const u32x2 a = __builtin_nontemporal_load((const u32x2*)(ya + c)), b = __builtin_nontemporal_load((const u32x2*)(yb + c));
            f32x4 m; m[0] = w0 * bf_lo(a.x) + w1 * bf_lo(b.x); m[1] = w0 * bf_hi(a.x) + w1 * bf_hi(b.x); m[2] = w0 * bf_lo(a.y) + w1 * bf_lo(b.y); m[3] = w0 * bf_hi(a.y) + w1 * bf_hi(b.y);
            xv[i] = x + g * m; }
        if (l == 1) { float* dst = outp + (size_t)row * DM;
#pragma unroll
            for (int i = 0; i < 8; ++i) __builtin_nontemporal_store(xv[i], (f32x4*)(dst + i * 256 + F.lane * 4)); }
        else { bf16_t* dst = (bf16_t*)(F.ws + WS_XL1) + (size_t)row * DM;
#pragma unroll
            for (int i = 0; i < 8; ++i) { u32x2 w; w.x = cvt_pk_bf16(xv[i][0], xv[i][1]); w.y = cvt_pk_bf16(xv[i][2], xv[i][3]); *(u32x2*)(dst + i * 256 + F.lane * 4) = w; } }
        if (l == 0) norm_mod_store_t(xv, tab, row, hb + (size_t)row * DM, F.lane, (unsigned char*)(F.ws + WS_HB8) + (size_t)row * DM);
    }
    if (l == 0) { __syncthreads();
        bg_range(F, CVT_Q_MOE0, CVT_Q_L1D); }
}

#ifdef ONLY_PH
#define IN(k) (((k) < 2 ? (k) : 2 + ((k) - 2) % 13) == ONLY_PH && lo <= (k) && (k) < hi)
#else
#define IN(k) (lo <= (k) && (k) < hi)
#endif
#define SEAM(k) do { if (IN((k) + 1) || rep_ + 1 < REPS(2 + (k) - pb)) xcd_barrier(bar); } while (0)
template <int l>
__device__ __forceinline__ void layer_body(const Frame& F, const int lo, const int hi, const XcdBarrier& bar) {
        const int pb = 2 + 13 * l;
        const int mrows = l == 0 ? TT : TL;
        const Frame FK = F;
#define GEMM_SITE() const Frame F = refresh(FK); const bf16_t* hb = (const bf16_t*)(F.ws + WS_HBUF); bf16_t* proj = (bf16_t*)(F.ws + WS_PROJ); (void)hb; (void)proj
        if (IN(pb + 0)) for (int rep_ = 0; rep_ < REPS(2 + 0); ++rep_) {
            GEMM_SITE();
            {
              pg8::SchedGrid S; S.init(TT, P_KR, F.G, F.bid, DM, DM); S.lda2 = (unsigned)DM; S.ldb2 = (unsigned)DM;
              EpiBf16 E{proj, PROJ_LD, 13, 37, 1 << 30, nullptr, 0, (float*)(F.ws + WS_SSQ) + (size_t)l * TT * 16, 4, (unsigned char*)(F.ws + WS_CQ8), 1.0f, (unsigned char*)(F.ws + WS_GT8), nullptr, 1.0f / 64};
              pg8::gemm_phase<EpiBf16, pg8::SchedGrid, DM, DM, DM, true>(F.lds, (const bf16_t*)(F.ws + WS_HB8), (const bf16_t*)(F.ws + WS_WIN8 + l * SZ_WIN8), S, E, F.wave); }
            SEAM(pb + 0); }
        if (IN(pb + 1)) {
            { GEMM_SITE();
              pg8::SchedGrid S; S.init(TT, 3584, F.G, F.bid, 1024, 512); S.lda2 = 1024u; S.ldb2 = 512u; S.split_pn = 6; S.aextra_lo = 0u; S.aextra_hi = 512u;
              EpiBf16 E{(bf16_t*)(F.ws + WS_QRAW), 1536, 0, 0, 6, (bf16_t*)(F.ws + WS_KVRAW), 2048, nullptr, 0, nullptr, 1.0f / 64, nullptr, (const float*)(F.ws + WS_SSQ) + (size_t)l * TT * 16, 1.0f / 512};
              pg8::gemm_phase<EpiBf16, pg8::SchedGrid, 512, 1024, 512, true>(F.lds, (const bf16_t*)(F.ws + WS_CQ8), (const bf16_t*)(F.ws + WS_WUP + l * SZ_WUP), S, E, F.wave); }
            phase_prep1(F, l, 0);
            if (IN(pb + 3)) xcd_barrier(bar); }
        if (IN(pb + 3)) for (int rep_ = 0; rep_ < REPS(2 + 3); ++rep_) { phase_prep2(F, l, ({ int d_ = (REPS(2 + 3) == 2 && rep_ == 0) ? 1 : 0; asm volatile("" : "+s"(d_)); d_; })); SEAM(pb + 3); }
        if (IN(pb + 4)) for (int rep_ = 0; rep_ < REPS(2 + 4); ++rep_) { phase_attn(F, l); SEAM(pb + 4); }
        if (IN(pb + 5)) for (int rep_ = 0; rep_ < REPS(2 + 5); ++rep_) {
            GEMM_SITE();
            const bf16_t* ocat = (const bf16_t*)(F.ws + WS_OCAT); bf16_t* y = (bf16_t*)(F.ws + WS_Y);
            pg8::SchedGrid S; S.init(TL, DM, F.G, F.bid, DM, DM); S.lda2 = (unsigned)DM; S.ldb2 = (unsigned)DM;
            EpiMerge E{(const unsigned char*)(F.ws + WS_GT8), 0, y, (unsigned char*)(F.ws + WS_Y8), 1.0f / 64};
            pg8::gemm_phase<EpiMerge, pg8::SchedGrid, DM, DM, DM, true>(F.lds, ocat, (const bf16_t*)(F.ws + WS_WOC8 + l * SZ_WOC8), S, E, F.wave);
            if (l == 0) {
                small_gemm_rows(F, ocat, DM, (const bf16_t*)(F.ws + WS_WOC + l * SZ_WOC), TL, TC, DM, [&](int r, int c, f32x4 p0, f32x4 p1, f32x4 p2, f32x4 p3) {
                    const bf16_t* gp = proj + (size_t)r * PROJ_LD + c;
                    const u32x2 a = *(const u32x2*)(gp + P_GA), b = *(const u32x2*)(gp + P_GB), cc = *(const u32x2*)(gp + P_GC);
                    const f32x4 pa = p0 + p1; f32x4 v;
                    v[0] = bf_lo(a.x) * pa[0] + bf_lo(b.x) * p2[0] + bf_lo(cc.x) * p3[0]; v[1] = bf_hi(a.x) * pa[1] + bf_hi(b.x) * p2[1] + bf_hi(cc.x) * p3[1];
                    v[2] = bf_lo(a.y) * pa[2] + bf_lo(b.y) * p2[2] + bf_lo(cc.y) * p3[2]; v[3] = bf_hi(a.y) * pa[3] + bf_hi(b.y) * p2[3] + bf_hi(cc.y) * p3[3];
                    u32x2 w; w.x = cvt_pk_bf16(v[0], v[1]); w.y = cvt_pk_bf16(v[2], v[3]); *(u32x2*)(y + (size_t)r * DM + c) = w; });
            }
            SEAM(pb + 5); }
        if (IN(pb + 6)) for (int rep_ = 0; rep_ < REPS(2 + 6); ++rep_) {
            GEMM_SITE();
            pg8::SchedGrid S; S.init(TL, DM, F.G, F.bid, DM, DM); S.lda2 = (unsigned)DM; S.ldb2 = (unsigned)DM;
            EpiOut<l != 0> E{l == 0 ? (const void*)inp(F, I_X) : (const void*)(F.ws + WS_XL1), l == 0 ? (const void*)inp(F, I_CTX) : (const void*)((const bf16_t*)(F.ws + WS_XL1) + (size_t)TL * DM),
                     (const float*)(F.ws + WS_MOD) + (size_t)l * 3 * 6 * DM, (bf16_t*)(F.ws + WS_XMID), 1.0f / 1024};
            pg8::gemm_phase<EpiOut<l != 0>, pg8::SchedGrid, DM, DM, DM, true>(F.lds, (const bf16_t*)(F.ws + WS_Y8), (const bf16_t*)(F.ws + WS_WOUT8 + l * SZ_WOUT8), S, E, F.wave);
            if (l == 0) {
                const float* cin = inp(F, I_CTX); const float* g1c = (const float*)(F.ws + WS_MOD) + (size_t)(2 * 6 + 2) * DM; bf16_t* xm = (bf16_t*)(F.ws + WS_XMID);
                small_gemm_rows(F, (const bf16_t*)(F.ws + WS_Y), DM, (const bf16_t*)(F.ws + WS_WOUT + l * SZ_WOUT), TL, TC, DM, [&](int r, int c, f32x4 p0, f32x4 p1, f32x4 p2, f32x4 p3) {
                    const f32x4 v = (p0 + p1) + (p2 + p3);
                    const f32x4 xn = *(const f32x4*)(cin + (size_t)(r - TL) * DM + c) + *(const f32x4*)(g1c + c) * v;
                    u32x2 w; w.x = cvt_pk_bf16(xn[0], xn[1]); w.y = cvt_pk_bf16(xn[2], xn[3]); *(u32x2*)(xm + (size_t)r * DM + c) = w; });
            }
            SEAM(pb + 6); }
        if (IN(pb + 7)) for (int rep_ = 0; rep_ < REPS(2 + 7); ++rep_) { phase_n2_router(F, l, mrows, ({ int d_ = (REPS(2 + 7) == 2 && rep_ == 0) ? 1 : 0; asm volatile("" : "+s"(d_)); d_; })); SEAM(pb + 9); }
        if (IN(pb + 10)) for (int rep_ = 0; rep_ < REPS(2 + 10); ++rep_) {
            GEMM_SITE();
            const int* tg = (const int*)(F.ws + WS_CTL) + CW_TILE + l * 384;
            pg8::SchedMoe<true> S; S.tile_e = tg; S.ntile = __builtin_amdgcn_readfirstlane(tg[128]); S.nnl_shift = 2; S.G = F.G; S.c = F.bid; S.lda2 = (unsigned)DM; S.ldb2 = (unsigned)DM;
            S.rlist = (const int*)(F.ws + WS_RLIST); S.cnt = (const unsigned*)(F.ws + WS_CTL) + CW_CNT + l * 32;
            EpiMoe1 E{(unsigned char*)(F.ws + WS_H), 1.0f / 64};
            pg8::gemm_phase<EpiMoe1, pg8::SchedMoe<true>, DM, DM, DM, true>(F.lds, (const bf16_t*)(F.ws + WS_HB8), (const bf16_t*)(F.ws + WS_WGU + l * SZ_WGU), S, E, F.wave);
            if (l == 1 && F.G == 256 && F.bid >= BG_M1B_BLK0) bg_idle(F, CVT_Q_ALL - BG_M1B_TASKS, F.bid - BG_M1B_BLK0, BG_M1B);
            if (l == 0 && F.G == 256 && F.bid >= BG_M1_BLK0) bg_idle(F, CVT_Q_L1D + 128 * 8 * BG_PER_WAVE, F.bid - BG_M1_BLK0, BG_M1);
            SEAM(pb + 10); }
        if (IN(pb + 11)) for (int rep_ = 0; rep_ < REPS(2 + 11); ++rep_) {
            GEMM_SITE();
            const int* tg = (const int*)(F.ws + WS_CTL) + CW_TILE + l * 384;
            pg8::SchedMoe<false> S; S.rlist = nullptr; S.cnt = nullptr; S.tile_e = tg; S.ntile = __builtin_amdgcn_readfirstlane(tg[128]); S.nnl_shift = 3; S.G = F.G; S.c = F.bid; S.lda2 = (unsigned)MOE_H; S.ldb2 = (unsigned)MOE_H;
            EpiDown E{(bf16_t*)(F.ws + WS_Y2S)};
            pg8::gemm_phase<EpiDown, pg8::SchedMoe<false>, MOE_H, MOE_H, MOE_H, true>(F.lds, (const bf16_t*)(F.ws + WS_H), (const bf16_t*)(F.ws + WS_WD + l * SZ_WD), S, E, F.wave);
            SEAM(pb + 11); }
        if (IN(pb + 12)) for (int rep_ = 0; rep_ < REPS(2 + 12); ++rep_) { phase_combine(F, l, mrows); SEAM(pb + 12); }
#undef GEMM_SITE
}
#undef IN
#undef SEAM

constexpr int N_PHASES = 2 + 13 * NLAYER;
__global__ void __launch_bounds__(512, 2) fwd(Params prm) {
    extern __shared__ __attribute__((aligned(16))) unsigned char shm[];
    Frame F; F.ws = prm.ws; F.lds = (LAS unsigned char*)shm; F.ldsg = (char*)shm;
    F.tid = threadIdx.x; F.lane = F.tid & 63; F.wave = __builtin_amdgcn_readfirstlane(F.tid >> 6); F.G = gridDim.x; F.bid = blockIdx.x; F.gw = F.bid * 8 + F.wave; F.nwt = F.G * 8;
    if (F.tid < 4) ((LAS unsigned*)(F.lds + MISC_OFF))[F.tid] = 0u;
    if (F.tid == 0) { LAS unsigned long long* pt = (LAS unsigned long long*)(F.lds + PTAB_OFF);
#pragma unroll
        for (int i = 0; i < 32; ++i) pt[i] = (unsigned long long)prm.in[i];
        pt[32] = (unsigned long long)prm.out; }
    __syncthreads();
    const int lo = prm.ph_lo, hi = prm.ph_hi;
    XcdBarrier bar; bar.bar = (unsigned*)(F.ws + WS_CTL) + CW_BAR; bar.x = 0; bar.st = nullptr; bar.wave = F.wave;
    if (hi - lo > 1) bar = xcd_barrier_post((unsigned*)(F.ws + WS_CTL) + CW_BAR, (volatile LAS unsigned*)(F.lds + MISC_OFF), F.wave);
#define IN(k) (lo <= (k) && (k) < hi)
#define SEAM(k) do { if (IN((k) + 1)) xcd_barrier(bar); } while (0)
    if (IN(0)) for (int rep_ = 0; rep_ < REPS(0); ++rep_) { phase0(F); if (IN(1) || rep_ + 1 < REPS(0)) xcd_barrier(bar); }
    if (IN(1)) for (int rep_ = 0; rep_ < REPS(1); ++rep_) { phase_norm(F, 0, 0, TT); if (IN(2) || rep_ + 1 < REPS(1)) xcd_barrier(bar); }
    layer_body<0>(F, lo, hi, bar);
    layer_body<1>(F, lo, hi, bar);
#undef IN
#undef SEAM
}

extern "C" void kernel_launch(void* const* d_in, const int* in_sizes, int n_in, void* d_out, int out_size, void* d_ws, size_t ws_size, hipStream_t stream) {
    static int grid = 0;
    if (grid == 0) {
        if (n_in != 32 || out_size != TL * DM || ws_size < WS_END) { fprintf(stderr, "kernel_launch: unexpected shapes: n_in %d out %d ws %zu (need %zu)\n", n_in, out_size, ws_size, (size_t)WS_END); grid = -1; return; }
        int dev = 0, cus = 0, per_cu = 0;
        if (hipGetDevice(&dev) != hipSuccess || hipDeviceGetAttribute(&cus, hipDeviceAttributeMultiprocessorCount, dev) != hipSuccess) { grid = -1; return; }
        if (hipFuncSetAttribute((const void*)fwd, hipFuncAttributeMaxDynamicSharedMemorySize, LDS_BYTES) != hipSuccess) { fprintf(stderr, "kernel_launch: hipFuncSetAttribute failed\n"); grid = -1; return; }
        if (hipOccupancyMaxActiveBlocksPerMultiprocessor(&per_cu, (const void*)fwd, 512, LDS_BYTES) != hipSuccess || per_cu < 1) fprintf(stderr, "kernel_launch: occupancy query reports %d blocks per CU\n", per_cu);
        (void)hipGetLastError();
        grid = cus;
    }
    if (grid < 0) return;
    (void)hipMemsetAsync((char*)d_ws + WS_CTL, 0, CTL_BYTES, stream);
    Params p{};
    for (int i = 0; i < 32; ++i) p.in[i] = (const float*)d_in[i];
    p.out = (float*)d_out; p.ws = (unsigned char*)d_ws;
#if MK_ONE_LAUNCH
    p.ph_lo = 0; p.ph_hi = N_PHASES;
    hipLaunchKernelGGL(fwd, dim3(grid), dim3(512), LDS_BYTES, stream, p);
#else
    for (int ph = 0; ph < N_PHASES; ++ph) { p.ph_lo = ph; p.ph_hi = ph + 1; hipLaunchKernelGGL(fwd, dim3(grid), dim3(512), LDS_BYTES, stream, p); }
#endif
    const hipError_t le = hipPeekAtLastError();
    if (le != hipSuccess) fprintf(stderr, "kernel_launch: launch failed: %s\n", hipGetErrorName(le));
}
```

```cpp
#include <hip/hip_runtime.h>
#include <stdint.h>
#include <stdio.h>

#ifndef REPMASK
#define REPMASK 0
#endif
#define REPS(k) (1 + ((REPMASK >> (k)) & 1))
#ifndef MK_ONE_LAUNCH
#define MK_ONE_LAUNCH 1
#endif

#define LAS __attribute__((address_space(3)))
#define GAS __attribute__((address_space(1)))
typedef unsigned short bf16_t;
typedef short bf16x8 __attribute__((ext_vector_type(8)));
typedef short s16x4 __attribute__((ext_vector_type(4)));
typedef float f32x4 __attribute__((ext_vector_type(4)));
typedef float f32x16 __attribute__((ext_vector_type(16)));
typedef unsigned u32x4 __attribute__((ext_vector_type(4)));
typedef unsigned u32x2 __attribute__((ext_vector_type(2)));

constexpr int DM = 2048, NB = 2, SEQ = 4096, TL = NB * SEQ, CL = 256, TC = NB * CL, TT = TL + TC, NLAYER = 2;
constexpr float EPS = 1e-6f;
constexpr float LOG2E = 1.4426950408889634f;
constexpr float THRL2 = 8.0f * LOG2E;
constexpr int IN_COLS = 9536;
constexpr int P_CQ = 0, P_CKV = 512, P_NAQ = 1024, P_NAK = 1536, P_NAV = 2048, P_GQ = 2560, P_GK = 3072, P_GV = 3200,
              P_GA = 3328, P_GB = 5376, P_GC = 7424, P_KR = 9472, PROJ_LD = 9728;
constexpr int NEXP = 32, MOE_H = 512;
constexpr int XS_ROWS = 25600;

constexpr size_t al256(size_t x) { return (x + 255) / 256 * 256; }
constexpr size_t WS_CTL = 0;
constexpr size_t CTL_BYTES = 65536;
constexpr size_t WS_MOD = WS_CTL + CTL_BYTES;
constexpr size_t WS_ROPE = WS_MOD + al256((size_t)NLAYER * 3 * 6 * DM * 4);
constexpr size_t WS_WIN = WS_ROPE + (size_t)SEQ * 32 * 8;
constexpr size_t SZ_WIN = (size_t)PROJ_LD * DM * 2;
constexpr size_t WS_WUP = WS_WIN + NLAYER * SZ_WIN;
constexpr size_t SZ_WUP = (size_t)3584 * 512 * 2;
constexpr size_t WS_WOC = WS_WUP + NLAYER * SZ_WUP;
constexpr size_t SZ_WOC = (size_t)2048 * 2048 * 2;
constexpr size_t WS_WOUT = WS_WOC + NLAYER * SZ_WOC;
constexpr size_t SZ_WOUT = (size_t)2048 * 2048 * 2;
constexpr size_t WS_WGU = WS_WOUT + NLAYER * SZ_WOUT;
constexpr size_t SZ_WGU = (size_t)NEXP * 1024 * 2048 * 2;
constexpr size_t WS_WD = WS_WGU + NLAYER * SZ_WGU;
constexpr size_t SZ_WD = (size_t)NEXP * 2048 * 512 * 2;
constexpr size_t WS_WR = WS_WD + NLAYER * SZ_WD;
constexpr size_t SZ_WR = (size_t)48 * 2048 * 2;
constexpr size_t WS_HBUF = WS_WR + NLAYER * SZ_WR;
constexpr size_t WS_OCAT = WS_HBUF + (size_t)TT * DM * 2;
constexpr size_t WS_YBUF = WS_OCAT + (size_t)TT * DM * 2;
constexpr size_t WS_Y = WS_YBUF + (size_t)TT * DM * 4;
constexpr size_t WS_XMID = WS_Y + (size_t)TT * DM * 2;
constexpr size_t WS_XL1 = WS_XMID + (size_t)TT * DM * 4;
constexpr size_t WS_TOK = WS_XL1 + (size_t)TT * DM * 4;
constexpr size_t SZ_TOK1 = al256((size_t)TT * 2 * 4);
constexpr size_t WS_SSQ = WS_TOK + 4 * SZ_TOK1;
constexpr size_t WS_HB8 = WS_SSQ + al256((size_t)NLAYER * TT * 16 * 4);
constexpr size_t WS_WIN8 = WS_HB8 + al256((size_t)TT * DM);
constexpr size_t SZ_WIN8 = (size_t)P_KR * DM;
constexpr size_t WS_WOUT8 = WS_WIN8 + NLAYER * SZ_WIN8;
constexpr size_t SZ_WOUT8 = (size_t)DM * DM;
constexpr size_t WS_Y8 = WS_WOUT8 + NLAYER * SZ_WOUT8;
constexpr size_t WS_WOC8 = WS_Y8 + (size_t)TL * DM;
constexpr size_t SZ_WOC8 = (size_t)DM * DM;
constexpr size_t WS_VT8 = WS_WOC8 + NLAYER * SZ_WOC8;
constexpr size_t WS_GT8 = WS_VT8 + (size_t)(TT / 64) * 8 * 8192;
constexpr size_t WS_CQ8 = WS_GT8 + (size_t)32 * 24 * 65536;
constexpr size_t WS_RLIST = WS_CQ8 + (size_t)TT * 1024;
constexpr size_t WS_R1 = WS_RLIST + al256((size_t)NEXP * TT * 4);
constexpr size_t WS_PROJ = WS_R1;
constexpr size_t WS_QRAW = WS_PROJ + (size_t)TT * PROJ_LD * 2;
constexpr size_t WS_KVRAW = WS_QRAW + (size_t)TT * 1536 * 2;
constexpr size_t WS_KM = WS_KVRAW + (size_t)TT * 2048 * 2;
constexpr size_t WS_R1_END = WS_KM + (size_t)TT * 1536 * 2;
constexpr size_t WS_XS = WS_R1;
constexpr size_t WS_H = WS_XS + (size_t)XS_ROWS * 2048 * 2;
constexpr size_t WS_Y2S = WS_H + (size_t)XS_ROWS * 512 * 2;
constexpr size_t WS_MOE_END = WS_Y2S + (size_t)XS_ROWS * 2048 * 2;
static_assert(WS_MOE_END <= WS_R1_END, "MoE buffers must fit the aliased region");
constexpr size_t WS_END = WS_R1_END;
static_assert(WS_END < 1280000000ull, "workspace budget");

constexpr int CW_BAR = 0;
constexpr int CW_CNT = 4096;
constexpr int CW_TILE = 4096 + 256;
constexpr int CW_DONE = 4096 + 128;

constexpr int LDS_STAGE = 131072;
constexpr int MISC_OFF = LDS_STAGE;
constexpr int LDS_BYTES = LDS_STAGE + 4096;

__device__ __forceinline__ unsigned cvt_pk_bf16(float lo, float hi) { unsigned r; asm volatile("v_cvt_pk_bf16_f32 %0, %1, %2" : "=v"(r) : "v"(lo), "v"(hi)); return r; }
__device__ __forceinline__ unsigned pk4_fp8(float a, float b, float c, float d) {
    a = fminf(fmaxf(a, -448.f), 448.f); b = fminf(fmaxf(b, -448.f), 448.f); c = fminf(fmaxf(c, -448.f), 448.f); d = fminf(fmaxf(d, -448.f), 448.f);
    int w = __builtin_amdgcn_cvt_pk_fp8_f32(a, b, 0, false); w = __builtin_amdgcn_cvt_pk_fp8_f32(c, d, w, true); return (unsigned)w;
}
__device__ __forceinline__ unsigned pk4_fp8_nc(float a, float b, float c, float d) { int w = __builtin_amdgcn_cvt_pk_fp8_f32(a, b, 0, false); w = __builtin_amdgcn_cvt_pk_fp8_f32(c, d, w, true); return (unsigned)w; }
__device__ __forceinline__ float bf_lo(unsigned w) { return __uint_as_float(w << 16); }
__device__ __forceinline__ float bf_hi(unsigned w) { return __uint_as_float(w & 0xffff0000u); }
__device__ __forceinline__ int lane_id() { return (int)__builtin_amdgcn_mbcnt_hi(~0u, __builtin_amdgcn_mbcnt_lo(~0u, 0u)); }
__device__ __forceinline__ float wave_sum(float v) {
#pragma unroll
    for (int o = 32; o > 0; o >>= 1) v += __shfl_xor(v, o);
    return v;
}
__device__ __forceinline__ void unpack8(const u32x4 w, float (&f)[8]);
__device__ __forceinline__ u32x4 pack8(const float (&f)[8]);
__device__ __forceinline__ float sigmoidf_(float x) { return __builtin_amdgcn_rcpf(1.0f + __expf(-x)); }
__device__ __forceinline__ float siluf_(float x) { return x * __builtin_amdgcn_rcpf(1.0f + __expf(-x)); }

#define XB_TMO      128
#define XB_XCNT(j)  (256  + 64 * (j))
#define XB_XSUB(j)  (1280 + 64 * (j))
#define XB_XGEN(j)  (2304 + 64 * (j))
#define XB_TOP      3328
#define XB_TOPGEN   3392
#define XCD_BAR_WORDS 3456
#define XB_SPIN_CAP (1u << 18)
__device__ __forceinline__ unsigned xb_ld(unsigned* p)              { return __hip_atomic_load(p, __ATOMIC_RELAXED, __HIP_MEMORY_SCOPE_AGENT); }
__device__ __forceinline__ unsigned xb_add(unsigned* p, unsigned v) { return __hip_atomic_fetch_add(p, v, __ATOMIC_RELAXED, __HIP_MEMORY_SCOPE_AGENT); }
__device__ __forceinline__ unsigned xb_xcc_id() { return (unsigned)__builtin_amdgcn_s_getreg((3 << 11) | 20) & 0xFu; }
#define XB_SPIN(cond, bar) do { unsigned _sp = 0; while (cond) { __builtin_amdgcn_s_sleep(1); \
    if ((++_sp & 255u) == 0u) { if (xb_ld(&(bar)[XB_TMO])) break; if (_sp > XB_SPIN_CAP) { atomicAdd(&(bar)[XB_TMO], 1u); break; } } } } while (0)
struct XcdBarrier { unsigned* bar; unsigned x; volatile LAS unsigned* st; int wave; };
__device__ __forceinline__ XcdBarrier xcd_barrier_post(unsigned* bar, volatile LAS unsigned* st, int wave) {
    XcdBarrier b; b.bar = bar; b.x = xb_xcc_id(); b.st = st; b.wave = wave;
    if (wave == 0 && lane_id() == 0) (void)xb_add(&bar[XB_XCNT(b.x)], 1u);
    return b;
}
__device__ __forceinline__ void xcd_barrier_complete(unsigned* bar, unsigned x, unsigned& nloc, unsigned& nx) {
    const unsigned G = gridDim.x * gridDim.y * gridDim.z;
    unsigned sum, cnt, mine, sp = 0u;
    for (;;) {
        sum = 0u; cnt = 0u; mine = 0u;
#pragma unroll
        for (unsigned j = 0; j < 16; ++j) { const unsigned c = xb_ld(&bar[XB_XCNT(j)]); sum += c; cnt += (c > 0u) ? 1u : 0u; mine = (j == x) ? c : mine; }
        if (sum == G) break;
        __builtin_amdgcn_s_sleep(1);
        if ((++sp & 255u) == 0u) { if (xb_ld(&bar[XB_TMO])) break; if (sp > XB_SPIN_CAP) { atomicAdd(&bar[XB_TMO], 1u); break; } }
    }
    nloc = mine > 0u ? mine : 1u; nx = cnt > 0u ? cnt : 1u;
}
__device__ __forceinline__ void xcd_barrier(const XcdBarrier& b) {
    asm volatile("s_waitcnt vmcnt(0)" ::: "memory");
    __syncthreads();
    if (b.wave == 0 && lane_id() == 0) {
        unsigned* bar = b.bar;
        __builtin_amdgcn_s_waitcnt(0);
        unsigned nloc = b.st[0], nx = b.st[1];
        if (nloc == 0u) { xcd_barrier_complete(bar, b.x, nloc, nx); b.st[0] = nloc; b.st[1] = nx; }
        const unsigned old = xb_add(&bar[XB_XSUB(b.x)], 1u);
        const unsigned gen = old / nloc;
        if (old + 1u == (gen + 1u) * nloc) {
            __builtin_amdgcn_fence(__ATOMIC_RELEASE, "agent");
            asm volatile("s_waitcnt vmcnt(0)" ::: "memory");
            const unsigned og = xb_add(&bar[XB_TOP], 1u);
            const unsigned tg = og / nx;
            if (og + 1u == (tg + 1u) * nx) xb_add(&bar[XB_TOPGEN], 1u);
            else XB_SPIN(xb_ld(&bar[XB_TOPGEN]) == tg, bar);
            __builtin_amdgcn_fence(__ATOMIC_ACQUIRE, "agent");
            xb_add(&bar[XB_XGEN(b.x)], 1u);
            asm volatile("s_waitcnt vmcnt(0)" ::: "memory");
        } else {
            XB_SPIN(xb_ld(&bar[XB_XGEN(b.x)]) == gen, bar);
            __builtin_amdgcn_fence(__ATOMIC_ACQUIRE, "agent");
            asm volatile("s_waitcnt vmcnt(0)" ::: "memory");
        }
    }
    __syncthreads();
}

struct Params { const float* in[32]; float* out; unsigned char* ws; int ph_lo, ph_hi; };
enum { I_X = 0, I_C, I_CTX, I_CCTX, I_ADAW, I_ADAB, I_NMIXG, I_NFFNG, I_WIN, I_MQNG, I_WUQ, I_MKVNG, I_WUKV, I_MQN, I_MKN,
       I_NAQN, I_NAKN, I_RPB, I_GQN, I_GKN, I_SINK, I_WOM, I_WON, I_WOG, I_WOUT, I_WGRP, I_BGRP, I_WEXP, I_BEXP, I_WG, I_WU, I_WDN };

struct Frame {
    unsigned char* ws; LAS unsigned char* lds; char* ldsg;
    int tid, lane, wave, G, bid, gw, nwt;
};

constexpr int PTAB_OFF = LDS_STAGE + 1024;
__device__ __forceinline__ const float* inp(const Frame& F, int i) {
    const LAS unsigned* t = (const LAS unsigned*)(F.lds + PTAB_OFF) + 2 * i;
    const unsigned lo = __builtin_amdgcn_readfirstlane(t[0]), hi = __builtin_amdgcn_readfirstlane(t[1]);
    return (const float*)(const GAS float*)(((unsigned long long)hi << 32) | lo);
}

__device__ __forceinline__ Frame refresh(const Frame& F0) {
    Frame F = F0; int t = F0.wave * 64 + lane_id(); asm volatile("" : "+v"(t));
    unsigned long long w = (unsigned long long)F.ws; int g = F.G, b = F.bid; asm volatile("" : "+s"(w), "+s"(g), "+s"(b));
    F.ws = (unsigned char*)(GAS unsigned char*)w; F.G = g; F.bid = b; F.nwt = g * 8;
    F.tid = t; F.lane = t & 63; F.wave = __builtin_amdgcn_readfirstlane(t >> 6); F.gw = F.bid * 8 + F.wave; return F;
}

namespace pg8 {
constexpr int BM = 256, BK = 64, HALF = 128, HTB = HALF * BK * 2, NXCD = 8, WGM = 8;
__device__ __forceinline__ int lds_byte(int r, int c) { const int st = (r >> 4) * 2 + (c >> 5), rr = r & 15, cc = c & 31, ob = rr * 64 + cc * 2; return st * 1024 + (ob ^ (((ob >> 9) & 1) << 5)); }
__device__ __forceinline__ void stage_rc(int b, int& R, int& C) { const int st = b / 1024, sb = b % 1024, swz = sb ^ (((sb >> 9) & 1) << 5); R = (st >> 1) * 16 + swz / 64; C = (st & 1) * 32 + (swz % 64) / 2; }
__device__ __forceinline__ int perm32(int rho) { const int n = rho >> 4, i = rho & 15; return 8 * (i >> 2) + 4 * n + (i & 3); }

struct Unit { unsigned aoff, boff; int pm, pn; int ge, glt, gcnt; };

struct SchedGrid {
    static constexpr bool GATHER = false;
    int nM, nN, nwg, G, c; unsigned lda2, ldb2; int split_pn; unsigned aextra_lo, aextra_hi;
    __device__ void init(int M, int N, int G_, int c_, int lda, int ldb) { nM = M / BM; nN = N / BM; nwg = nM * nN; G = G_; c = c_; lda2 = (unsigned)lda * 2u; ldb2 = (unsigned)ldb * 2u; split_pn = 1 << 30; aextra_lo = 0; aextra_hi = 0; }
    __device__ bool next(int i, Unit& u) const {
        const long L = (long)i * G + c; if (L >= nwg) return false;
        int wgid = (int)L; { const int q = nwg / NXCD, r = nwg % NXCD, xcd = wgid % NXCD, off = wgid / NXCD; wgid = (xcd < r ? xcd * (q + 1) : r * (q + 1) + (xcd - r) * q) + off; }
        const int nig = WGM * nN, gid = wgid / nig, fm = gid * WGM, gsz = (nM - fm) < WGM ? (nM - fm) : WGM;
        u.pm = fm + ((wgid % nig) % gsz); u.pn = (wgid % nig) / gsz;
        u.aoff = (unsigned)u.pm * BM * lda2 + (u.pn < split_pn ? aextra_lo : aextra_hi);
        u.boff = (unsigned)u.pn * BM * ldb2; u.ge = 0; u.glt = 0; u.gcnt = 0;
        return true;
    }
};
template <bool GATHER_>
struct SchedMoe {
    static constexpr bool GATHER = GATHER_;
    const int* tile_e; int ntile, nnl_shift, G, c; unsigned lda2, ldb2;
    const int* rlist; const unsigned* cnt;
    __device__ bool next(int i, Unit& u) const {
        const long L = (long)i * G + c; if (L >= ((long)ntile << nnl_shift)) return false;
        const int pm = (int)(L >> nnl_shift), pnl = (int)(L & ((1 << nnl_shift) - 1));
        const int e = __builtin_amdgcn_readfirstlane(tile_e[pm]);
        u.pm = pm; u.pn = pnl; u.aoff = GATHER_ ? 0u : (unsigned)pm * BM * lda2; u.boff = (unsigned)((e << nnl_shift) + pnl) * BM * ldb2;
        if (GATHER_) { u.ge = e; u.glt = __builtin_amdgcn_readfirstlane(tile_e[160 + pm]); u.gcnt = (int)__builtin_amdgcn_readfirstlane(cnt[e]); }
        return true;
    }
};

typedef int i32x8 __attribute__((ext_vector_type(8)));
__device__ __forceinline__ void mfma_f8_acc(f32x4& acc, i32x8 a, i32x8 b, int sc) {
    asm volatile("v_mfma_scale_f32_16x16x128_f8f6f4 %0, %1, %2, %0, %3, %3 op_sel_hi:[0,0,0]" : "+v"(acc) : "v"(a), "v"(b), "v"(sc));
}
template <class Epi, class Sched, int K, int lda, int ldb, bool F8 = false>
__device__ __forceinline__ void gemm_phase(LAS unsigned char* lds, const bf16_t* Abase, const bf16_t* Bbase, const Sched& S, const Epi& E, const int wave_) {
    int tid_ = wave_ * 64 + lane_id(); asm volatile("" : "+v"(tid_));
    const int tid = tid_, wid = __builtin_amdgcn_readfirstlane(tid >> 6), lane = tid & 63, wr = wid >> 2, wc = wid & 3, fr = lane & 15, fq = lane >> 4;
    constexpr int ES = F8 ? 1 : 2; constexpr int nt = K * ES / (BK * 2);
    unsigned voffA[2], voffB[2];
#pragma unroll
    for (int i = 0; i < 2; ++i) { int R, C; stage_rc(tid * 16 + i * 8192, R, C); const int Rb = Epi::PERM ? ((R & ~31) + perm32(R & 31)) : R;
        voffA[i] = (unsigned)(R * lda * ES + C * 2); voffB[i] = (unsigned)(Rb * ldb * ES + C * 2); }
    unsigned vgA_c[2][2] = {{0u, 0u}, {0u, 0u}}, vgA_n[2][2] = {{0u, 0u}, {0u, 0u}}; int Rv[2] = {0, 0}, Cv[2] = {0, 0};
    if constexpr (Sched::GATHER) {
#pragma unroll
        for (int i = 0; i < 2; ++i) stage_rc(tid * 16 + i * 8192, Rv[i], Cv[i]); }
#define PG8_GTOK(X, U) do { _Pragma("unroll") for (int _h = 0; _h < 2; ++_h) _Pragma("unroll") for (int _i = 0; _i < 2; ++_i) { int _lr = (U).glt * 256 + _h * 128 + Rv[_i]; _lr = _lr < (U).gcnt ? _lr : 0; \
        X[_h][_i] = (unsigned)S.rlist[(size_t)(U).ge * TT + _lr]; } } while (0)
#define PG8_GOFF(X) do { _Pragma("unroll") for (int _h = 0; _h < 2; ++_h) _Pragma("unroll") for (int _i = 0; _i < 2; ++_i) X[_h][_i] = X[_h][_i] * (unsigned)(lda * ES) + (unsigned)Cv[_i] * 2u; } while (0)
    constexpr size_t kstep = (size_t)(BK * 2);
    constexpr size_t hstepA = (size_t)HALF * lda * ES, hstepB = (size_t)HALF * ldb * ES;
    const unsigned ldsw = (unsigned)wid * 1024u;
    const int aoff = lds_byte(wr * 64 + fr, fq * 8), boff = lds_byte(wc * 32 + fr, fq * 8);
#define PG8_SA(b, h) (((b) * 2 + (h)) * HTB)
#define PG8_SB(b, h) ((4 + (b) * 2 + (h)) * HTB)
#define PG8_STAGE(bufoff, gbase, voff) do { _Pragma("unroll") for (int _i = 0; _i < 2; ++_i) \
        __builtin_amdgcn_global_load_lds((const unsigned*)((const char*)(gbase) + (voff)[_i]), (LAS unsigned*)(lds + (bufoff) + ldsw + _i * 8192), 16, 0, 0); } while (0)
#define PG8_STAGE_A(bufoff, gbase, h, nx) do { if constexpr (Sched::GATHER) { const unsigned _vv[2] = {(nx) ? vgA_n[h][0] : vgA_c[h][0], (nx) ? vgA_n[h][1] : vgA_c[h][1]}; PG8_STAGE(bufoff, gbase, _vv); } \
        else PG8_STAGE(bufoff, (gbase) + (h) * hstepA, voffA); } while (0)
#define PG8_LDA(dst, b, h) do { _Pragma("unroll") for (int m = 0; m < 4; ++m) _Pragma("unroll") for (int k = 0; k < 2; ++k) dst[m][k] = *(const LAS u32x4*)(lds + PG8_SA(b, h) + aoff + m * 2048 + k * 1024); } while (0)
#define PG8_LDB(dst, b, h) do { _Pragma("unroll") for (int n = 0; n < 2; ++n) _Pragma("unroll") for (int k = 0; k < 2; ++k) dst[n][k] = *(const LAS u32x4*)(lds + PG8_SB(b, h) + boff + n * 2048 + k * 1024); } while (0)
#define PG8_CAT(X, Y) __builtin_bit_cast(i32x8, __builtin_shufflevector((X), (Y), 0, 1, 2, 3, 4, 5, 6, 7))
#define PG8_MMA(ai, bj, At, Bt) do { __builtin_amdgcn_s_setprio(1); \
        if constexpr (F8) { _Pragma("unroll") for (int m = 0; m < 4; ++m) _Pragma("unroll") for (int n = 0; n < 2; ++n) \
            mfma_f8_acc(acc[ai][bj][m][n], PG8_CAT(Bt[n][0], Bt[n][1]), PG8_CAT(At[m][0], At[m][1]), f8_unit_scale); } \
        else { _Pragma("unroll") for (int m = 0; m < 4; ++m) _Pragma("unroll") for (int n = 0; n < 2; ++n) _Pragma("unroll") for (int k = 0; k < 2; ++k) \
            acc[ai][bj][m][n] = __builtin_amdgcn_mfma_f32_16x16x32_bf16(__builtin_bit_cast(bf16x8, Bt[n][k]), __builtin_bit_cast(bf16x8, At[m][k]), acc[ai][bj][m][n], 0, 0, 0); } \
        __builtin_amdgcn_s_setprio(0); } while (0)
#define PG8_WAIT_V(n) asm volatile("s_waitcnt vmcnt(" #n ")" ::: "memory")
#define PG8_WAIT_L(n) asm volatile("s_waitcnt lgkmcnt(" #n ")" ::: "memory")
#define PG8_BAR __builtin_amdgcn_s_barrier()
#define PG8_SCHED __builtin_amdgcn_sched_barrier(0)
#define PG8_KLOOP(TB, TE) do { \
        for (int t = (TB); t < (TE); t += 2) { \
            const bool last = (t == nt - 2); \
            const char* a1 = cA + (size_t)(t + 1) * kstep; \
            const char* a2 = last ? nA : cA + (size_t)(t + 2) * kstep; const char* b2 = last ? nB : cB + (size_t)(t + 2) * kstep; \
            const char* a3 = a2 + kstep; const char* b3 = b2 + kstep; \
            if constexpr (Sched::GATHER) { if (t == nt - 4) PG8_GOFF(vgA_n); } \
            PG8_LDB(B0, 0, 0); PG8_SCHED; PG8_LDA(At, 0, 0); PG8_STAGE_A(PG8_SA(1, 1), a1, 1, false); \
            PG8_WAIT_L(8); PG8_BAR; PG8_WAIT_L(0); PG8_MMA(0, 0, At, B0); PG8_BAR; PG8_SCHED; \
            PG8_LDB(B1, 0, 1); PG8_STAGE(PG8_SB(0, 0), b2, voffB); \
            PG8_BAR; PG8_WAIT_L(0); PG8_MMA(0, 1, At, B1); PG8_BAR; \
            PG8_LDA(At, 0, 1); PG8_STAGE_A(PG8_SA(0, 0), a2, 0, last); \
            PG8_BAR; PG8_WAIT_L(0); PG8_MMA(1, 0, At, B0); PG8_BAR; PG8_SCHED; \
            PG8_STAGE(PG8_SB(0, 1), b2 + hstepB, voffB); \
            PG8_WAIT_V(6); PG8_BAR; PG8_MMA(1, 1, At, B1); PG8_BAR; \
            PG8_LDB(B0, 1, 0); PG8_SCHED; PG8_LDA(At, 1, 0); PG8_STAGE_A(PG8_SA(0, 1), a2, 1, last); \
            PG8_WAIT_L(8); PG8_BAR; PG8_WAIT_L(0); PG8_MMA(0, 0, At, B0); PG8_BAR; PG8_SCHED; \
            PG8_LDB(B1, 1, 1); PG8_STAGE(PG8_SB(1, 0), b3, voffB); \
            PG8_BAR; PG8_WAIT_L(0); PG8_MMA(0, 1, At, B1); PG8_BAR; \
            PG8_LDA(At, 1, 1); PG8_STAGE_A(PG8_SA(1, 0), a3, 0, last); \
            PG8_BAR; PG8_WAIT_L(0); PG8_MMA(1, 0, At, B0); PG8_BAR; PG8_SCHED; \
            PG8_STAGE(PG8_SB(1, 1), b3 + hstepB, voffB); \
            PG8_WAIT_V(6); PG8_BAR; PG8_MMA(1, 1, At, B1); PG8_BAR; \
        } \
        } while (0)
    int f8_unit_scale = 0x7f7f7f7f; asm volatile("" : "+v"(f8_unit_scale)); (void)f8_unit_scale;
    Unit cur, nxt; int ui = 0;
    if (!S.next(0, cur)) return;
    f32x4 acc[2][2][4][2];
#pragma unroll
    for (int a = 0; a < 2; ++a)
#pragma unroll
        for (int b = 0; b < 2; ++b)
#pragma unroll
            for (int m = 0; m < 4; ++m)
#pragma unroll
                for (int n = 0; n < 2; ++n) acc[a][b][m][n] = (f32x4){0.f, 0.f, 0.f, 0.f};
    u32x4 At[4][2], B0[2][2], B1[2][2];
    const char* cA = (const char*)Abase + cur.aoff; const char* cB = (const char*)Bbase + cur.boff;
    if constexpr (Sched::GATHER) { PG8_GTOK(vgA_c, cur); PG8_GOFF(vgA_c); }
    PG8_STAGE(PG8_SB(0, 0), cB, voffB); PG8_STAGE_A(PG8_SA(0, 0), cA, 0, false); PG8_STAGE(PG8_SB(0, 1), cB + hstepB, voffB); PG8_STAGE_A(PG8_SA(0, 1), cA, 1, false);
    if (wr == 1) PG8_BAR;
    PG8_WAIT_V(4); PG8_BAR;
    PG8_STAGE(PG8_SB(1, 0), cB + kstep, voffB); PG8_STAGE_A(PG8_SA(1, 0), cA + kstep, 0, false); PG8_STAGE(PG8_SB(1, 1), cB + hstepB + kstep, voffB);
    PG8_WAIT_V(6); PG8_BAR;
    for (;;) {
        const bool has_next = S.next(ui + 1, nxt);
        const char* nA = has_next ? (const char*)Abase + nxt.aoff : cA; const char* nB = has_next ? (const char*)Bbase + nxt.boff : cB;
        if constexpr (Sched::GATHER) { if (has_next) PG8_GTOK(vgA_n, nxt); else PG8_GTOK(vgA_n, cur); }
        if constexpr (Epi::MID) {
            constexpr int t1 = 1024 * ES / (BK * 2), t2 = 1536 * ES / (BK * 2);
            PG8_KLOOP(0, t1); if constexpr (F8) asm volatile("s_nop 7\n\ts_nop 7\n\ts_nop 7" ::: "memory"); E.mid(acc, cur, 0, wr, wc, fr, fq);
            PG8_KLOOP(t1, t2); if constexpr (F8) asm volatile("s_nop 7\n\ts_nop 7\n\ts_nop 7" ::: "memory"); E.mid(acc, cur, 1, wr, wc, fr, fq); PG8_KLOOP(t2, nt);
        } else { PG8_KLOOP(0, nt); }
        if constexpr (F8) asm volatile("s_nop 7\n\ts_nop 7\n\ts_nop 7" ::: "memory");
        E(acc, cur, wr, wc, fr, fq);
        if (!has_next) break;
#pragma unroll
        for (int a = 0; a < 2; ++a)
#pragma unroll
            for (int b = 0; b < 2; ++b)
#pragma unroll
                for (int m = 0; m < 4; ++m)
#pragma unroll
                    for (int n = 0; n < 2; ++n) acc[a][b][m][n] = (f32x4){0.f, 0.f, 0.f, 0.f};
        cur = nxt; cA = nA; cB = nB; ++ui;
        if constexpr (Sched::GATHER) {
#pragma unroll
            for (int _h = 0; _h < 2; ++_h)
#pragma unroll
                for (int _i = 0; _i < 2; ++_i) vgA_c[_h][_i] = vgA_n[_h][_i]; }
    }
    PG8_WAIT_V(0);
    if (wr == 0) PG8_BAR;
    PG8_BAR;
#undef PG8_KLOOP
#undef PG8_GTOK
#undef PG8_GOFF
#undef PG8_STAGE_A
#undef PG8_SA
#undef PG8_SB
#undef PG8_STAGE
#undef PG8_LDA
#undef PG8_LDB
#undef PG8_MMA
#undef PG8_CAT
#undef PG8_WAIT_V
#undef PG8_WAIT_L
#undef PG8_BAR
#undef PG8_SCHED
}
}

typedef f32x4 AccT[2][2][4][2];
struct EpiBf16 {
    static constexpr bool PERM = true, MID = false;
    bf16_t* O; int ldc; int sig_lo, sig_hi;
    int split_pn; bf16_t* O2; int ldc2;
    float* ssq_acc; int ssq_tiles;
    unsigned char* cq8; float cs2;
    unsigned char* gt8;
    const float* rs; float rs_inv_n;
    __device__ __forceinline__ void operator()(const AccT& acc, const pg8::Unit& u, int wr, int wc, int fr, int fq) const {
        const int row0 = u.pm * 256 + wr * 64 + fr;
        const bool second = u.pn >= split_pn;
        if (ssq_acc && u.pn < ssq_tiles) {
#pragma unroll
            for (int ai = 0; ai < 2; ++ai)
#pragma unroll
                for (int m = 0; m < 4; ++m) { float sq = 0.f;
#pragma unroll
                    for (int bj = 0; bj < 2; ++bj)
#pragma unroll
                        for (int n = 0; n < 2; ++n) { const f32x4 v = acc[ai][bj][m][n]; sq += (v[0] * v[0] + v[1] * v[1]) + (v[2] * v[2] + v[3] * v[3]); }
                    sq += __shfl_xor(sq, 16); sq += __shfl_xor(sq, 32); if (!rs && rs_inv_n != 0.f) sq *= rs_inv_n * rs_inv_n;
                    if (fq == 0) ssq_acc[(size_t)(row0 + ai * 128 + m * 16) * 16 + (u.pn >> 1) * 8 + (u.pn & 1) * 4 + wc] = sq; } }
        float rsc[2][4];
#pragma unroll
        for (int ai = 0; ai < 2; ++ai)
#pragma unroll
            for (int m = 0; m < 4; ++m) { rsc[ai][m] = (!rs && rs_inv_n != 0.f) ? rs_inv_n : 1.0f;
                if (rs) { const f32x4* pq = (const f32x4*)(rs + (size_t)(row0 + ai * 128 + m * 16) * 16 + (second ? 8 : 0)); const f32x4 a = pq[0], b = pq[1];
                    rsc[ai][m] = rsqrtf((((a[0] + a[1]) + (a[2] + a[3])) + ((b[0] + b[1]) + (b[2] + b[3]))) * rs_inv_n + EPS) * cs2; } }
        if (cq8 && ssq_acc && u.pn < ssq_tiles) {
            unsigned char* tp = cq8 + (size_t)row0 * 1024 + u.pn * 256 + wc * 32 + 8 * fq;
#pragma unroll
            for (int ai = 0; ai < 2; ++ai)
#pragma unroll
                for (int m = 0; m < 4; ++m)
#pragma unroll
                    for (int bj = 0; bj < 2; ++bj) { const f32x4 v0 = acc[ai][bj][m][0] * rsc[ai][m], v1 = acc[ai][bj][m][1] * rsc[ai][m];
                        u32x2 w; w.x = pk4_fp8(v0[0], v0[1], v0[2], v0[3]); w.y = pk4_fp8(v1[0], v1[1], v1[2], v1[3]);
                        *(u32x2*)(tp + (size_t)(ai * 128 + m * 16) * 1024 + bj * 128) = w; }
            return; }
        bf16_t* base = second ? O2 : O; const int ld = second ? ldc2 : ldc; const int pn = second ? u.pn - split_pn : u.pn;
        const int col0 = pn * 256 + wc * 32 + 8 * fq;
        const bool sig = (u.pn >= sig_lo) && (u.pn < sig_hi);
        if (sig && gt8 && u.pm < 32) {
            unsigned char* tp = gt8 + ((size_t)(u.pm * 24 + (u.pn - sig_lo)) * 8 + (wr * 4 + wc)) * 8192 + (fq * 16 + fr) * 8;
#pragma unroll
            for (int ai = 0; ai < 2; ++ai)
#pragma unroll
                for (int m = 0; m < 4; ++m)
#pragma unroll
                    for (int bj = 0; bj < 2; ++bj) { u32x2 w; unsigned b[8];
#pragma unroll
                        for (int j = 0; j < 4; ++j) { b[j] = (unsigned)fminf(sigmoidf_(acc[ai][bj][m][0][j] * rsc[ai][m]) * 256.0f, 255.0f); b[4 + j] = (unsigned)fminf(sigmoidf_(acc[ai][bj][m][1][j] * rsc[ai][m]) * 256.0f, 255.0f); }
                        w.x = b[0] | (b[1] << 8) | (b[2] << 16) | (b[3] << 24); w.y = b[4] | (b[5] << 8) | (b[6] << 16) | (b[7] << 24);
                        *(u32x2*)(tp + ((ai * 4 + m) * 2 + bj) * 512) = w; }
            return; }
#pragma unroll
        for (int ai = 0; ai < 2; ++ai)
#pragma unroll
            for (int m = 0; m < 4; ++m) { bf16_t* rowp = base + (size_t)(row0 + ai * 128 + m * 16) * ld + col0;
#pragma unroll
                for (int bj = 0; bj < 2; ++bj) { f32x4 v0 = acc[ai][bj][m][0] * rsc[ai][m], v1 = acc[ai][bj][m][1] * rsc[ai][m];
                    if (sig) {
#pragma unroll
                        for (int j = 0; j < 4; ++j) { v0[j] = sigmoidf_(v0[j]); v1[j] = sigmoidf_(v1[j]); } }
                    u32x4 w; w.x = cvt_pk_bf16(v0[0], v0[1]); w.y = cvt_pk_bf16(v0[2], v0[3]); w.z = cvt_pk_bf16(v1[0], v1[1]); w.w = cvt_pk_bf16(v1[2], v1[3]);
                    *(u32x4*)(rowp + bj * 128) = w; } }
    }
};
struct EpiDown {
    static constexpr bool PERM = true, MID = false;
    bf16_t* O;
    __device__ __forceinline__ void operator()(const AccT& acc, const pg8::Unit& u, int wr, int wc, int fr, int fq) const {
        bf16_t* base = O + (size_t)(u.pm * 256 + wr * 64 + fr) * DM + u.pn * 256 + wc * 32 + 8 * fq;
#pragma unroll
        for (int ai = 0; ai < 2; ++ai)
#pragma unroll
            for (int m = 0; m < 4; ++m)
#pragma unroll
                for (int bj = 0; bj < 2; ++bj) { const f32x4 v0 = acc[ai][bj][m][0] * (1.0f / 32), v1 = acc[ai][bj][m][1] * (1.0f / 32);
                    u32x4 w; w.x = cvt_pk_bf16(v0[0], v0[1]); w.y = cvt_pk_bf16(v0[2], v0[3]); w.z = cvt_pk_bf16(v1[0], v1[1]); w.w = cvt_pk_bf16(v1[2], v1[3]);
                    *(u32x4*)(base + (size_t)(ai * 128 + m * 16) * DM + bj * 128) = w; }
    }
};
struct EpiMerge {
    static constexpr bool PERM = true, MID = true;
    const unsigned char* gt8; int ldg_unused; bf16_t* y; unsigned char* y8; float ys;
    __device__ __forceinline__ void scale_by(AccT& acc, const pg8::Unit& u, int gnum, int gden, int wr, int wc, int fr, int fq) const {
        unsigned loff = (unsigned)(((wr * 4 + wc) * 8192) + (fq * 16 + fr) * 8); asm volatile("" : "+v"(loff));
        const unsigned char* nb = gt8 + (size_t)(u.pm * 24 + gnum + u.pn) * 65536; const unsigned char* db = gt8 + (size_t)(u.pm * 24 + (gden < 0 ? gnum : gden) + u.pn) * 65536;
        u32x2 nw[2][4][2], dw[2][4][2];
#pragma unroll
        for (int ai = 0; ai < 2; ++ai)
#pragma unroll
            for (int m = 0; m < 4; ++m)
#pragma unroll
                for (int bj = 0; bj < 2; ++bj) { nw[ai][m][bj] = *(const u32x2*)(nb + loff + ((ai * 4 + m) * 2 + bj) * 512); if (gden >= 0) dw[ai][m][bj] = *(const u32x2*)(db + loff + ((ai * 4 + m) * 2 + bj) * 512); }
#pragma unroll
        for (int ai = 0; ai < 2; ++ai)
#pragma unroll
            for (int m = 0; m < 4; ++m)
#pragma unroll
                for (int bj = 0; bj < 2; ++bj) { float nf[8];
#pragma unroll
                    for (int j = 0; j < 4; ++j) { nf[j] = (float)((nw[ai][m][bj].x >> (8 * j)) & 0xffu) + 0.5f; nf[4 + j] = (float)((nw[ai][m][bj].y >> (8 * j)) & 0xffu) + 0.5f; }
                    if (gden >= 0) {
#pragma unroll
                        for (int j = 0; j < 4; ++j) { nf[j] *= __builtin_amdgcn_rcpf((float)((dw[ai][m][bj].x >> (8 * j)) & 0xffu) + 0.5f); nf[4 + j] *= __builtin_amdgcn_rcpf((float)((dw[ai][m][bj].y >> (8 * j)) & 0xffu) + 0.5f); } }
                    else {
#pragma unroll
                        for (int j = 0; j < 8; ++j) nf[j] *= (1.0f / 256); }
#pragma unroll
                    for (int j = 0; j < 4; ++j) { acc[ai][bj][m][0][j] *= nf[j]; acc[ai][bj][m][1][j] *= nf[4 + j]; } }
    }
    __device__ __forceinline__ void mid(AccT& acc, const pg8::Unit& u, int t, int wr, int wc, int fr, int fq) const {
        if (t == 0) scale_by(acc, u, 0, 8, wr, wc, fr, fq); else scale_by(acc, u, 8, 16, wr, wc, fr, fq);
    }
    __device__ __forceinline__ void operator()(AccT& acc, const pg8::Unit& u, int wr, int wc, int fr, int fq) const {
        scale_by(acc, u, 16, -1, wr, wc, fr, fq);
        const int row0 = u.pm * 256 + wr * 64 + fr, col0 = u.pn * 256 + wc * 32 + 8 * fq;
#pragma unroll
        for (int ai = 0; ai < 2; ++ai)
#pragma unroll
            for (int m = 0; m < 4; ++m) { unsigned char* rowp = y8 + (size_t)(row0 + ai * 128 + m * 16) * DM + col0;
#pragma unroll
                for (int bj = 0; bj < 2; ++bj) { const f32x4 v0 = acc[ai][bj][m][0] * ys, v1 = acc[ai][bj][m][1] * ys;
                    u32x2 w; w.x = pk4_fp8(v0[0], v0[1], v0[2], v0[3]); w.y = pk4_fp8(v1[0], v1[1], v1[2], v1[3]);
                    *(u32x2*)(rowp + bj * 128) = w; } }
    }
};
template <bool XB>
struct EpiOut {
    static constexpr bool PERM = true, MID = false;
    const void* xlat; const void* xctx;
    const float* modl;
    bf16_t* xmid; float cs;
    __device__ __forceinline__ void operator()(const AccT& acc, const pg8::Unit& u, int wr, int wc, int fr, int fq) const {
        constexpr int XE = XB ? 2 : 4;
        const int rt = u.pm * 256; const bool lat = rt < TL; const int v = lat ? (rt >> 12) : 2;
        const char* xs = (const char*)(lat ? xlat : xctx) + (size_t)(lat ? rt : rt - TL) * DM * XE;
        char* xo = (char*)(xmid + (size_t)rt * DM);
        const int col0 = u.pn * 256 + wc * 32 + 8 * fq;
        const float* g1 = modl + (size_t)v * 6 * DM + 2 * DM + col0;
        f32x4 g[2][2];
#pragma unroll
        for (int bj = 0; bj < 2; ++bj)
#pragma unroll
            for (int n = 0; n < 2; ++n) g[bj][n] = *(const f32x4*)(g1 + bj * 128 + n * 4) * cs;
        unsigned loff = (unsigned)((wr * 64 + fr) * DM + col0); asm volatile("" : "+v"(loff));
#pragma unroll
        for (int ai = 0; ai < 2; ++ai) {
            f32x4 xr[4][2][2];
#pragma unroll
            for (int m = 0; m < 4; ++m)
#pragma unroll
                for (int bj = 0; bj < 2; ++bj) { const unsigned e = loff + (unsigned)((ai * 128 + m * 16) * DM + bj * 128);
                    if constexpr (XB) { const u32x4 w = *(const u32x4*)(xs + (size_t)e * 2);
                        xr[m][bj][0] = (f32x4){bf_lo(w.x), bf_hi(w.x), bf_lo(w.y), bf_hi(w.y)}; xr[m][bj][1] = (f32x4){bf_lo(w.z), bf_hi(w.z), bf_lo(w.w), bf_hi(w.w)}; }
                    else { xr[m][bj][0] = *(const f32x4*)(xs + (size_t)e * 4); xr[m][bj][1] = *(const f32x4*)(xs + (size_t)e * 4 + 16); } }
#pragma unroll
            for (int m = 0; m < 4; ++m)
#pragma unroll
                for (int bj = 0; bj < 2; ++bj) { const unsigned e = loff + (unsigned)((ai * 128 + m * 16) * DM + bj * 128);
                    const f32x4 v0 = xr[m][bj][0] + g[bj][0] * acc[ai][bj][m][0], v1 = xr[m][bj][1] + g[bj][1] * acc[ai][bj][m][1];
                    u32x4 w; w.x = cvt_pk_bf16(v0[0], v0[1]); w.y = cvt_pk_bf16(v0[2], v0[3]); w.z = cvt_pk_bf16(v1[0], v1[1]); w.w = cvt_pk_bf16(v1[2], v1[3]);
                    *(u32x4*)(xo + (size_t)e * 2) = w; }
            asm volatile("" ::: "memory");
        }
    }
};
struct EpiMoe1 {
    static constexpr bool PERM = true, MID = false;
    unsigned char* H; float WS;
    __device__ __forceinline__ void operator()(const AccT& acc, const pg8::Unit& u, int wr, int wc, int fr, int fq) const {
        const int row0 = u.pm * 256 + wr * 64 + fr, col0 = u.pn * 128 + wc * 32 + 8 * fq;
#pragma unroll
        for (int ai = 0; ai < 2; ++ai)
#pragma unroll
            for (int m = 0; m < 4; ++m) { unsigned char* rowp = H + (size_t)(row0 + ai * 128 + m * 16) * MOE_H + col0;
                f32x4 h0, h1;
#pragma unroll
                for (int j = 0; j < 4; ++j) { h0[j] = siluf_(acc[ai][0][m][0][j] * WS) * (acc[ai][1][m][0][j] * WS); h1[j] = siluf_(acc[ai][0][m][1][j] * WS) * (acc[ai][1][m][1][j] * WS); }
                u32x2 w; w.x = pk4_fp8(h0[0], h0[1], h0[2], h0[3]); w.y = pk4_fp8(h1[0], h1[1], h1[2], h1[3]);
                *(u32x2*)rowp = w; }
    }
};

#define KSWZ(row, colB) ((row) * 256 + ((colB) ^ (((row) & 7) << 4)))
__device__ __forceinline__ int crow(int r, int hi) { return (r & 3) + 8 * (r >> 2) + 4 * hi; }
__device__ __forceinline__ int v_st(int k, int c) { const int kk = (k & ~0xC) | ((k & 4) << 1) | ((k & 8) >> 1); return ((kk >> 3) * 4 + (c >> 5)) * 512 + ((kk & 7) * 32 + (c & 31)) * 2; }
__device__ __forceinline__ int v_rd_base(int lane) { return ((lane & 3) << 3) | (((lane >> 2) & 3) << 6) | (((lane >> 4) & 1) << 5) | (((lane >> 5) & 1) << 8); }
constexpr int v_rd_off(int d0, int ks, int half) { return d0 * 512 + ks * 4096 + half * 2048; }
template <int OFF> __device__ __forceinline__ s16x4 tr_read(int vb) {
    s16x4 r; asm volatile("ds_read_b64_tr_b16 %0, %1 offset:%2" : "=&v"(r) : "v"(vb), "i"(OFF) : "memory"); return r;
}
struct VFrag { s16x4 l0, h0, l1, h1; };
template <int D0, int HF> __device__ __forceinline__ void pv_reads(VFrag& v, int vb) {
    v.l0 = tr_read<v_rd_off(D0, 2 * HF, 0)>(vb); v.h0 = tr_read<v_rd_off(D0, 2 * HF, 1)>(vb); v.l1 = tr_read<v_rd_off(D0, 2 * HF + 1, 0)>(vb); v.h1 = tr_read<v_rd_off(D0, 2 * HF + 1, 1)>(vb);
}
__device__ __forceinline__ void pv_mma(f32x16& od, const VFrag& v, bf16x8 pa0, bf16x8 pa1) {
#define PKV(L, H) (bf16x8){L[0], L[1], L[2], L[3], H[0], H[1], H[2], H[3]}
    od = __builtin_amdgcn_mfma_f32_32x32x16_bf16(pa0, PKV(v.l0, v.h0), od, 0, 0, 0);
    od = __builtin_amdgcn_mfma_f32_32x32x16_bf16(pa1, PKV(v.l1, v.h1), od, 0, 0, 0);
#undef PKV
}

struct AttnCx {
    const bf16_t* Qb; int ldq;
    int qwoff;
    const bf16_t* Kb; int ldk; const bf16_t* Vb; int ldv;
    bf16_t* Ob; int ldo; int owoff; unsigned char* Ob8;
    int qtok0;
    int qmap;
    int nt, nloc, ktok_loc0, ktok_ctx0;
    float scale_l2;
    int na_r0, na_kr0; const float* bias;
    const float* mq_gain; const float2* mq_rope;
    int gq_pos0, gq_kpos0; const float* sink; int local;
};
__device__ __forceinline__ int attn_qtok(const AttnCx& cx, int w, int r32) {
    return cx.qmap == 0 ? cx.qtok0 + w * 32 + r32 : (cx.qmap == 1 ? cx.qtok0 + (w >> 1) * 64 + (w & 1) * 32 + r32 : cx.qtok0 + (w & 1) * 32 + r32);
}

typedef int i32x8 __attribute__((ext_vector_type(8)));
__device__ __forceinline__ constexpr int qk_off(int c, int hi) { return c < 4 ? (c >> 1) * 64 + hi * 32 + (c & 1) * 16 : 128 + (c & 1) * 32 + hi * 16; }
constexpr int K8LD = 208;
constexpr int V8LD = 80;
constexpr float P8THR = 8.0f, P8OFF = 5.0f;
template <int DQ, int DV, int MODE>
__device__ __forceinline__ void attn_item(char* lds, const AttnCx& cx, const int wave_) {
    constexpr int ND0 = DQ / 16, NDV = DV / 32, CPR = DQ / 8, NKC = 64 * CPR / 512, CPRV = DV / 8, NVC = 64 * CPRV / 512;
    constexpr int KBUF = 32768, VBUF = 16384;
    int tid_ = wave_ * 64 + lane_id(); asm volatile("" : "+v"(tid_));
    const int tid = tid_, wid = __builtin_amdgcn_readfirstlane(tid >> 6), lane = tid & 63, r32 = lane & 31, hi = lane >> 5;
    char* Kl = lds; char* Vl = lds + 2 * KBUF;
    float* scr = (float*)(lds + 2 * KBUF + 2 * VBUF) + wid * 64; float* li_l = scr; float* al_l = scr + 32;
    const bf16_t* qp = cx.Qb + (size_t)attn_qtok(cx, wid, r32) * cx.ldq + (wid >> 1) * cx.qwoff + hi * 8;
    bf16x8 qr[ND0]; i32x8 qf[3]; int f8sc = 0x7f7f7f7f; (void)qf; (void)f8sc;
    if constexpr (MODE != 0) {
#pragma unroll
        for (int d0 = 0; d0 < ND0; ++d0) qr[d0] = *(const bf16x8*)(qp + d0 * 16);
    }
    if constexpr (MODE == 0) {
        const int qtok = attn_qtok(cx, wid, r32); const bool lat = qtok < TL; const float2* cs = cx.mq_rope + (size_t)(qtok & (SEQ - 1)) * 32 + hi * 16;
        const bf16_t* q0 = cx.Qb + (size_t)qtok * cx.ldq;
        float qv[6][16];
#pragma unroll
        for (int c = 0; c < 6; ++c) { const int d = c < 4 ? (c >> 1) * 64 + hi * 32 + (c & 1) * 16 : 128 + (c & 1) * 32 + hi * 16;
            const u32x4 w0 = *(const u32x4*)(q0 + d), w1 = *(const u32x4*)(q0 + d + 8);
            float f[8]; unpack8(w0, f);
#pragma unroll
            for (int e = 0; e < 8; ++e) qv[c][e] = f[e];
            unpack8(w1, f);
#pragma unroll
            for (int e = 0; e < 8; ++e) qv[c][8 + e] = f[e]; }
        float ss = 0.f;
#pragma unroll
        for (int c = 0; c < 6; ++c)
#pragma unroll
            for (int e = 0; e < 16; ++e) ss += qv[c][e] * qv[c][e];
        { auto rr = __builtin_amdgcn_permlane32_swap(__float_as_uint(ss), __float_as_uint(ss), false, false); ss = __uint_as_float(rr[0]) + __uint_as_float(rr[1]); }
        const float rn = rsqrtf(ss * (1.0f / 192) + EPS);
#pragma unroll
        for (int c = 0; c < 6; ++c) { const int d = c < 4 ? (c >> 1) * 64 + hi * 32 + (c & 1) * 16 : 128 + (c & 1) * 32 + hi * 16; const float* g = cx.mq_gain + d;
#pragma unroll
            for (int e = 0; e < 16; ++e) qv[c][e] *= rn * g[e]; }
        if (lat) {
#pragma unroll
            for (int e = 0; e < 16; ++e) { const float x1 = qv[4][e], x2 = qv[5][e]; const float2 c = cs[e]; qv[4][e] = x1 * c.x - x2 * c.y; qv[5][e] = x1 * c.y + x2 * c.x; } }
#pragma unroll
        for (int m = 0; m < 3; ++m) { i32x8 w;
#pragma unroll
            for (int k = 0; k < 2; ++k)
#pragma unroll
                for (int q4 = 0; q4 < 4; ++q4) w[k * 4 + q4] = (int)pk4_fp8(qv[2 * m + k][q4 * 4], qv[2 * m + k][q4 * 4 + 1], qv[2 * m + k][q4 * 4 + 2], qv[2 * m + k][q4 * 4 + 3]);
            qf[m] = w; }
        asm volatile("" : "+v"(f8sc));
    }
    f32x16 o[NDV];
#pragma unroll
    for (int d = 0; d < NDV; ++d)
#pragma unroll
        for (int r = 0; r < 16; ++r) o[d][r] = 0.f;
    float m_reg = -1e30f, l_reg = 0.f;
    bf16x8 ks[NKC], vs[NVC];
    const int vb0 = (int)(uintptr_t)Vl + v_rd_base(lane);
#define AT_TOK(t) ((t) < cx.nloc ? cx.ktok_loc0 + (t) * 64 : cx.ktok_ctx0 + ((t) - cx.nloc) * 64)
#define AT_LOAD(t) do { const int _tok = AT_TOK(t); \
    if constexpr (MODE == 0) { const unsigned char* _kb = (const unsigned char*)cx.Kb;     \
        { const int row = tid / 12, c = tid % 12; ks[0] = *(const bf16x8*)(_kb + (size_t)(_tok + row) * cx.ldk + c * 16); } \
        if (tid < 256) { const int ci = 512 + tid, row = ci / 12, c = ci % 12; ks[1] = *(const bf16x8*)(_kb + (size_t)(_tok + row) * cx.ldk + c * 16); } } \
    else { _Pragma("unroll") for (int _i = 0; _i < NKC; ++_i) { const int ci = tid + _i * 512, row = ci / CPR, c8 = ci % CPR; ks[_i] = *(const bf16x8*)(cx.Kb + (size_t)(_tok + row) * cx.ldk + c8 * 8); } } \
    if constexpr (MODE == 0) { vs[0] = *(const bf16x8*)((const unsigned char*)cx.Vb + (size_t)(_tok >> 6) * 65536 + tid * 16); }     \
    else { _Pragma("unroll") for (int _i = 0; _i < NVC; ++_i) { const int ci = tid + _i * 512, row = ci / CPRV, c8 = ci % CPRV; vs[_i] = *(const bf16x8*)(cx.Vb + (size_t)(_tok + row) * cx.ldv + c8 * 8); } } } while (0)
#define AT_WRITE(b) do { \
    if constexpr (MODE == 0) { { const int row = tid / 12, c = tid % 12; *(bf16x8*)(Kl + (b) * KBUF + row * K8LD + c * 16) = ks[0]; } \
        if (tid < 256) { const int ci = 512 + tid, row = ci / 12, c = ci % 12; *(bf16x8*)(Kl + (b) * KBUF + row * K8LD + c * 16) = ks[1]; } } \
    else { _Pragma("unroll") for (int _i = 0; _i < NKC; ++_i) { const int ci = tid + _i * 512, row = ci / CPR, dim = (ci % CPR) * 8; *(bf16x8*)(Kl + (b) * KBUF + (dim >> 7) * 16384 + KSWZ(row, (dim & 127) * 2)) = ks[_i]; } } \
    if constexpr (MODE == 0) { *(bf16x8*)(Vl + (b) * VBUF + (tid >> 2) * V8LD + (tid & 3) * 16) = vs[0]; } \
    else { _Pragma("unroll") for (int _i = 0; _i < NVC; ++_i) { const int ci = tid + _i * 512, row = ci / CPRV, c = (ci % CPRV) * 8; *(bf16x8*)(Vl + (b) * VBUF + v_st(row, c)) = vs[_i]; } } } while (0)
    AT_LOAD(0); AT_WRITE(0); __syncthreads();
    const int nt = cx.nt;
    const int wq = wid >> 1, wh = wid & 1;
    const int na_r = cx.na_r0 + wq, na_rs = min(max(na_r - 4, 0), 56), na_c = wh * 32 + r32, na_cs = min(max(na_c - 8, 0), 48);
    const int gq_pos = cx.gq_pos0 + wh * 32 + r32;
    if constexpr (MODE == 0) {
        const float Cs = cx.scale_l2; const int NH = 2 * nt;
        if (nt > 1) AT_LOAD(1);
        f32x16 sc, sn; float al_c;
#define AT_QK(S, KT, HF) do { _Pragma("unroll") for (int r = 0; r < 16; ++r) S[r] = 0.f; \
        const char* _kr = (KT) + ((HF) * 32 + r32) * K8LD + hi * 32; \
        _Pragma("unroll") for (int m = 0; m < 3; ++m) { const int o0 = m < 2 ? m * 64 : 128 - hi * 16, o1 = m < 2 ? m * 64 + 16 : 160 - hi * 16; \
            const u32x4 k0 = *(const u32x4*)(_kr + o0), k1 = *(const u32x4*)(_kr + o1); \
            S = __builtin_amdgcn_mfma_scale_f32_32x32x64_f8f6f4(__builtin_bit_cast(i32x8, __builtin_shufflevector(k0, k1, 0, 1, 2, 3, 4, 5, 6, 7)), qf[m], S, 0, 0, 0, f8sc, 0, f8sc); } } while (0)
#define AT_PARTIAL(S, AL) do { float pmax = S[0]; _Pragma("unroll") for (int r = 1; r < 16; ++r) pmax = fmaxf(pmax, S[r]); \
        { auto rr = __builtin_amdgcn_permlane32_swap(__float_as_uint(pmax), __float_as_uint(pmax), false, false); pmax = fmaxf(__uint_as_float(rr[0]), __uint_as_float(rr[1])); } \
        pmax *= Cs; float mn = m_reg; AL = 1.f; if (!__all(pmax - m_reg <= P8THR)) { mn = fmaxf(m_reg, pmax - P8OFF); AL = __builtin_amdgcn_exp2f(m_reg - mn); m_reg = mn; } \
        _Pragma("unroll") for (int r = 0; r < 16; ++r) S[r] = fmaf(S[r], Cs, -mn); } while (0)
        AT_QK(sc, Kl, 0); AT_PARTIAL(sc, al_c);
        u32x4 p_lo = {0u, 0u, 0u, 0u}, p_hi = {0u, 0u, 0u, 0u};
        const char* v8b = Vl + r32 * V8LD + hi * 32;
#define AT_PV2(D0, VR) do { const u32x4 a0 = *(const u32x4*)((VR) + (D0) * 32 * V8LD), a1 = *(const u32x4*)((VR) + (D0) * 32 * V8LD + 16); \
              const u32x4 b0 = *(const u32x4*)((VR) + ((D0) + 1) * 32 * V8LD), b1 = *(const u32x4*)((VR) + ((D0) + 1) * 32 * V8LD + 16); \
              asm volatile("s_waitcnt lgkmcnt(0)" ::: "memory"); __builtin_amdgcn_sched_barrier(0); \
              o[D0] = __builtin_amdgcn_mfma_scale_f32_32x32x64_f8f6f4(pA, __builtin_bit_cast(i32x8, __builtin_shufflevector(a0, a1, 0, 1, 2, 3, 4, 5, 6, 7)), o[D0], 0, 0, 0, f8sc, 0, f8sc); \
              o[(D0) + 1] = __builtin_amdgcn_mfma_scale_f32_32x32x64_f8f6f4(pA, __builtin_bit_cast(i32x8, __builtin_shufflevector(b0, b1, 0, 1, 2, 3, 4, 5, 6, 7)), o[(D0) + 1], 0, 0, 0, f8sc, 0, f8sc); } while (0)
#define AT_STEP(H, NEXT) do { \
            const int t = j >> 1, buf = t & 1; \
            if (NEXT) { if (H == 0) AT_QK(sn, Kl + buf * KBUF, 1); else AT_QK(sn, Kl + (buf ^ 1) * KBUF, 0); } \
            _Pragma("unroll") for (int r = 0; r < 16; ++r) sc[r] = __builtin_amdgcn_exp2f(sc[r]); \
            float ps = 0.f; \
            _Pragma("unroll") for (int r = 0; r < 16; ++r) ps += sc[r]; \
            { auto rr = __builtin_amdgcn_permlane32_swap(__float_as_uint(ps), __float_as_uint(ps), false, false); ps = __uint_as_float(rr[0]) + __uint_as_float(rr[1]); } \
            l_reg = l_reg * al_c + ps; \
            { u32x4 pw; pw.x = pk4_fp8_nc(sc[0], sc[1], sc[2], sc[3]); pw.y = pk4_fp8_nc(sc[4], sc[5], sc[6], sc[7]); pw.z = pk4_fp8_nc(sc[8], sc[9], sc[10], sc[11]); pw.w = pk4_fp8_nc(sc[12], sc[13], sc[14], sc[15]);     \
              if (H == 0) p_lo = pw; else p_hi = pw; } \
            if (__any(al_c < 1.f)) { \
                if (hi == 0) al_l[r32] = al_c; \
                asm volatile("s_waitcnt lgkmcnt(0)" ::: "memory"); \
                _Pragma("unroll") for (int r = 0; r < 16; ++r) { const float a = al_l[crow(r, hi)]; _Pragma("unroll") for (int d = 0; d < NDV; ++d) o[d][r] *= a; } \
                if (H == 1) {     \
                    _Pragma("unroll") for (int q4 = 0; q4 < 4; ++q4) { const int w = (int)p_lo[q4]; \
                        p_lo[q4] = pk4_fp8(__builtin_amdgcn_cvt_f32_fp8(w, 0) * al_c, __builtin_amdgcn_cvt_f32_fp8(w, 1) * al_c, __builtin_amdgcn_cvt_f32_fp8(w, 2) * al_c, __builtin_amdgcn_cvt_f32_fp8(w, 3) * al_c); } } \
            } \
            if (H == 1) { const char* vr = v8b + buf * VBUF; const i32x8 pA = __builtin_bit_cast(i32x8, __builtin_shufflevector(p_lo, p_hi, 0, 1, 2, 3, 4, 5, 6, 7)); \
              AT_PV2(0, vr); AT_PV2(2, vr); } \
            if (NEXT) { AT_PARTIAL(sn, al_c); _Pragma("unroll") for (int r = 0; r < 16; ++r) sc[r] = sn[r]; } \
            if (H == 0) { if (t + 1 < nt) { AT_WRITE(buf ^ 1); if (t + 2 < nt) AT_LOAD(t + 2); } } \
            __syncthreads(); } while (0)
        for (int j = 0; j < NH - 2; j += 2) { AT_STEP(0, true); { const int j0 = j; const int j = j0 + 1; AT_STEP(1, true); } }
        { const int j = NH - 2; AT_STEP(0, true); }
        { const int j = NH - 1; AT_STEP(1, false); }
#undef AT_PV2
#undef AT_STEP
#undef AT_QK
#undef AT_PARTIAL
    } else
    for (int t = 0; t < nt; ++t) {
        const int buf = t & 1;
        if (t + 1 < nt) AT_LOAD(t + 1);
        bool skip = false;
        if (MODE == 1) { if (t < cx.nloc) { const int kr = cx.na_kr0 + t; skip = (kr < na_rs) || (kr >= na_rs + 8); } }
        if (MODE == 2) { if (cx.local && t < cx.nloc) { const int kp0 = cx.gq_kpos0 + t * 64; const int q0 = cx.gq_pos0 + wh * 32; skip = (kp0 + 63 < q0 - 128) || (kp0 > q0 + 31 + 128); } }
        if (!skip) {
            const char* Kt = Kl + buf * KBUF; const int vb = vb0 + buf * VBUF; const float Cs = cx.scale_l2;
#pragma unroll
            for (int hf = 0; hf < 2; ++hf) {
                f32x16 pp;
#pragma unroll
                for (int r = 0; r < 16; ++r) pp[r] = 0.f;
#pragma unroll
                for (int d0 = 0; d0 < ND0; ++d0) { const int pan = d0 >> 3, cb = ((d0 & 7) * 16 + hi * 8) * 2;
                    const bf16x8 bk = *(const bf16x8*)(Kt + pan * 16384 + KSWZ(hf * 32 + r32, cb));
                    pp = __builtin_amdgcn_mfma_f32_32x32x16_bf16(bk, qr[d0], pp, 0, 0, 0); }
                VFrag vf[2];
                if (hf == 0) { pv_reads<0, 0>(vf[0], vb); pv_reads<1, 0>(vf[1], vb); } else { pv_reads<0, 1>(vf[0], vb); pv_reads<1, 1>(vf[1], vb); }
                if (MODE == 1 && t < cx.nloc) {
                    int na_cs_t = na_cs; asm volatile("" : "+v"(na_cs_t));
                    const int kr = cx.na_kr0 + t; const float* brow = cx.bias + (kr - na_r + 7) * 31 + 15 - na_c;
#pragma unroll
                    for (int r = 0; r < 16; ++r) { const int kc = hf * 32 + crow(r, hi);
                        const bool v = (kc >= na_cs_t) && (kc < na_cs_t + 16);
                        const float bb = brow[v ? kc : na_c];
                        pp[r] = v ? fmaf(pp[r], Cs, bb) : -INFINITY; }
                } else if (MODE == 2 && cx.local && t < cx.nloc) {
                    int gq_pos_t = gq_pos; asm volatile("" : "+v"(gq_pos_t));
                    const int kp0 = cx.gq_kpos0 + t * 64 + hf * 32 - gq_pos_t;
#pragma unroll
                    for (int r = 0; r < 16; ++r) { const int dd = kp0 + crow(r, hi);
                        pp[r] = (dd >= -128 && dd <= 128) ? pp[r] * Cs : -INFINITY; }
                } else {
#pragma unroll
                    for (int r = 0; r < 16; ++r) pp[r] *= Cs;
                }
                float pmax = pp[0];
#pragma unroll
                for (int r = 1; r < 16; ++r) pmax = fmaxf(pmax, pp[r]);
                { auto rr = __builtin_amdgcn_permlane32_swap(__float_as_uint(pmax), __float_as_uint(pmax), false, false);
                  pmax = fmaxf(__uint_as_float(rr[0]), __uint_as_float(rr[1])); }
                float mn = m_reg, alpha = 1.f;
                if (!__all(pmax - m_reg <= THRL2)) { mn = fmaxf(m_reg, pmax); alpha = __builtin_amdgcn_exp2f(m_reg - mn); m_reg = mn; }
#pragma unroll
                for (int r = 0; r < 16; ++r) pp[r] = __builtin_amdgcn_exp2f(pp[r] - mn);
                float ps = 0.f;
#pragma unroll
                for (int r = 0; r < 16; ++r) ps += pp[r];
                { auto rr = __builtin_amdgcn_permlane32_swap(__float_as_uint(ps), __float_as_uint(ps), false, false);
                  ps = __uint_as_float(rr[0]) + __uint_as_float(rr[1]); }
                l_reg = l_reg * alpha + ps;
                bf16x8 pa0, pa1;
#define PK4(P, BASE, OUT) do { unsigned a0 = cvt_pk_bf16(P[BASE + 0], P[BASE + 1]), a1 = cvt_pk_bf16(P[BASE + 2], P[BASE + 3]);   \
    unsigned b0 = cvt_pk_bf16(P[BASE + 4], P[BASE + 5]), b1 = cvt_pk_bf16(P[BASE + 6], P[BASE + 7]);                              \
    auto r0 = __builtin_amdgcn_permlane32_swap(a0, b0, false, false); auto r1 = __builtin_amdgcn_permlane32_swap(a1, b1, false, false); \
    u32x4 w = {r0[0], r1[0], r0[1], r1[1]}; OUT = *reinterpret_cast<bf16x8*>(&w); } while (0)
                PK4(pp, 0, pa0); PK4(pp, 8, pa1);
#undef PK4
                if (__any(alpha < 1.f)) {
                    if (hi == 0) al_l[r32] = alpha;
                    asm volatile("s_waitcnt lgkmcnt(0)" ::: "memory");
#pragma unroll
                    for (int r = 0; r < 16; ++r) { const float a = al_l[crow(r, hi)];
#pragma unroll
                        for (int d = 0; d < NDV; ++d) o[d][r] *= a; }
                }
                asm volatile("s_waitcnt lgkmcnt(0)" ::: "memory"); __builtin_amdgcn_sched_barrier(0);
                if constexpr (NDV == 4) {
                    VFrag vg[2];
                    if (hf == 0) { pv_reads<2, 0>(vg[0], vb); pv_reads<3, 0>(vg[1], vb); } else { pv_reads<2, 1>(vg[0], vb); pv_reads<3, 1>(vg[1], vb); }
                    pv_mma(o[0], vf[0], pa0, pa1); pv_mma(o[1], vf[1], pa0, pa1);
                    asm volatile("s_waitcnt lgkmcnt(0)" ::: "memory"); __builtin_amdgcn_sched_barrier(0);
                    pv_mma(o[2], vg[0], pa0, pa1); pv_mma(o[3], vg[1], pa0, pa1);
                } else { pv_mma(o[0], vf[0], pa0, pa1); pv_mma(o[1], vf[1], pa0, pa1); }
            }
        }
        if (t + 1 < nt) AT_WRITE(buf ^ 1);
        __syncthreads();
    }
    if (MODE == 2) { const float sk = cx.sink[wq] * LOG2E; l_reg += __builtin_amdgcn_exp2f(sk - m_reg); }
    if (hi == 0) li_l[r32] = l_reg;
    asm volatile("s_waitcnt lgkmcnt(0)" ::: "memory");
    if (cx.Ob8) {
        unsigned char* Ow = cx.Ob8 + (wid >> 1) * cx.owoff + r32;
#pragma unroll
        for (int r = 0; r < 16; ++r) { const int j = crow(r, hi); const float rl = __builtin_amdgcn_rcpf(li_l[j]) * 16.0f;
            unsigned char* op = Ow + (size_t)attn_qtok(cx, wid, j) * cx.ldo;
            if constexpr (NDV == 4) { const unsigned w = pk4_fp8(o[0][r] * rl, o[1][r] * rl, o[2][r] * rl, o[3][r] * rl);
                op[0] = (unsigned char)(w & 0xffu); op[32] = (unsigned char)((w >> 8) & 0xffu); op[64] = (unsigned char)((w >> 16) & 0xffu); op[96] = (unsigned char)(w >> 24); }
            else { const unsigned w = pk4_fp8(o[0][r] * rl, o[1][r] * rl, 0.f, 0.f); op[0] = (unsigned char)(w & 0xffu); op[32] = (unsigned char)((w >> 8) & 0xffu); } }
    } else {
    bf16_t* Ow = cx.Ob + (wid >> 1) * cx.owoff + r32;
#pragma unroll
    for (int r = 0; r < 16; ++r) { const int j = crow(r, hi); const float rl = __builtin_amdgcn_rcpf(li_l[j]);
        bf16_t* op = Ow + (size_t)attn_qtok(cx, wid, j) * cx.ldo;
#pragma unroll
        for (int d = 0; d < NDV; ++d) { const unsigned w = cvt_pk_bf16(o[d][r] * rl, 0.f); op[d * 32] = (bf16_t)(w & 0xffffu); } }
    }
    __syncthreads();
#undef AT_TOK
#undef AT_LOAD
#undef AT_WRITE
}

constexpr int CVT_LDS_OFF = 40960, CVT_LDS_WAVE = 64 * 144;
__device__ __forceinline__ void cvt_task(const Frame& F, const float* src, size_t ldsrc, int sc0, int k0, bf16_t* dst, int ldd, int dcol0, int dmode, int dbase, const float* rowgain) {
    const int lane = F.lane;
    LAS unsigned char* T = F.lds + CVT_LDS_OFF + F.wave * CVT_LDS_WAVE;
    if (sc0 >= 0) {
        const float* sp = src + (size_t)(k0 + 16 * (lane >> 4)) * ldsrc + sc0 + 4 * (lane & 15);
        f32x4 v[16];
#pragma unroll
        for (int u = 0; u < 16; ++u) v[u] = __builtin_nontemporal_load((const f32x4*)(sp + (size_t)u * ldsrc));
        if (rowgain) {
#pragma unroll
            for (int u = 0; u < 16; ++u) v[u] *= rowgain[k0 + 16 * (lane >> 4) + u]; }
#pragma unroll
        for (int j = 0; j < 4; ++j) { u32x4 w0, w1;
            w0.x = cvt_pk_bf16(v[0][j], v[1][j]); w0.y = cvt_pk_bf16(v[2][j], v[3][j]); w0.z = cvt_pk_bf16(v[4][j], v[5][j]); w0.w = cvt_pk_bf16(v[6][j], v[7][j]);
            w1.x = cvt_pk_bf16(v[8][j], v[9][j]); w1.y = cvt_pk_bf16(v[10][j], v[11][j]); w1.z = cvt_pk_bf16(v[12][j], v[13][j]); w1.w = cvt_pk_bf16(v[14][j], v[15][j]);
            LAS unsigned char* tp = T + (4 * (lane & 15) + j) * 144 + (lane >> 4) * 32;
            *(LAS u32x4*)tp = w0; *(LAS u32x4*)(tp + 16) = w1; }
    }
    asm volatile("s_waitcnt lgkmcnt(0)" ::: "memory");
#pragma unroll
    for (int i = 0; i < 8; ++i) { const int c = i * 64 + lane, n = c >> 3, ch = c & 7;
        u32x4 w = {0u, 0u, 0u, 0u}; if (sc0 >= 0) w = *(const LAS u32x4*)(T + n * 144 + ch * 16);
        const int hn = dbase + n; const size_t drow = dmode == 0 ? (size_t)hn : (size_t)((hn >> 7) * 256 + (hn & 127));
        *(u32x4*)(dst + drow * (size_t)ldd + dcol0 + k0 + ch * 8) = w; }
    asm volatile("s_waitcnt lgkmcnt(0)" ::: "memory");
}
__device__ __forceinline__ void cvt_task8(const Frame& F, const float* src, size_t ldsrc, int sc0, int k0, unsigned char* dst, int ldd, int dmode, int dbase, float wscale, const float* rowgain = nullptr) {
    const int lane = F.lane;
    LAS unsigned char* T = F.lds + CVT_LDS_OFF + F.wave * CVT_LDS_WAVE;
    const float* sp = src + (size_t)(k0 + 16 * (lane >> 4)) * ldsrc + sc0 + 4 * (lane & 15);
    f32x4 v[16];
#pragma unroll
    for (int u = 0; u < 16; ++u) v[u] = __builtin_nontemporal_load((const f32x4*)(sp + (size_t)u * ldsrc));
    if (rowgain) {
#pragma unroll
        for (int u = 0; u < 16; ++u) v[u] *= rowgain[k0 + 16 * (lane >> 4) + u]; }
#pragma unroll
    for (int j = 0; j < 4; ++j) { u32x4 w;
        w.x = pk4_fp8(v[0][j] * wscale, v[1][j] * wscale, v[2][j] * wscale, v[3][j] * wscale); w.y = pk4_fp8(v[4][j] * wscale, v[5][j] * wscale, v[6][j] * wscale, v[7][j] * wscale);
        w.z = pk4_fp8(v[8][j] * wscale, v[9][j] * wscale, v[10][j] * wscale, v[11][j] * wscale); w.w = pk4_fp8(v[12][j] * wscale, v[13][j] * wscale, v[14][j] * wscale, v[15][j] * wscale);
        *(LAS u32x4*)(T + (4 * (lane & 15) + j) * 80 + (lane >> 4) * 16) = w; }
    asm volatile("s_waitcnt lgkmcnt(0)" ::: "memory");
#pragma unroll
    for (int i = 0; i < 4; ++i) { const int c = i * 64 + lane, n = c >> 2, ch = c & 3;
        const u32x4 w = *(const LAS u32x4*)(T + n * 80 + ch * 16);
        const int hn = dbase + n; const size_t drow = dmode == 0 ? (size_t)hn : (size_t)((hn >> 7) * 256 + (hn & 127));
        *(u32x4*)(dst + drow * (size_t)ldd + k0 + ch * 16) = w; }
    asm volatile("s_waitcnt lgkmcnt(0)" ::: "memory");
}
constexpr int CVT_DENSE = 7360, CVT_EXP = 768, CVT_LAYER = CVT_DENSE + CVT_EXP * NEXP;
__device__ __forceinline__ void cvt_do(const Frame& F, const int t) {
        const int l = t / CVT_LAYER; int r = t % CVT_LAYER;
        const float* src; bf16_t* dst; const float* rowgain = nullptr; int K, N, cb, kc, sc0, ldd = 0, dcol0 = 0, dmode = 0, dbase = 0; bool is_wout = false, is_wo = false; int wup_row0 = -1;
        if (r < CVT_DENSE) {
            if (r < 4864) { K = 2048; N = IN_COLS; src = inp(F, I_WIN) + (size_t)l * DM * IN_COLS; dst = (bf16_t*)(F.ws + WS_WIN + l * SZ_WIN); }
            else if (r < 5056) { r -= 4864; K = 512; N = 1536; src = inp(F, I_WUQ) + (size_t)l * 512 * 1536; dst = (bf16_t*)(F.ws + WS_WUP + l * SZ_WUP); rowgain = inp(F, I_MQNG) + l * 512; wup_row0 = 0; }
            else if (r < 5312) { r -= 5056; K = 512; N = 2048; src = inp(F, I_WUKV) + (size_t)l * 512 * 2048; dst = (bf16_t*)(F.ws + WS_WUP + l * SZ_WUP) + (size_t)1536 * 512; rowgain = inp(F, I_MKVNG) + l * 512; wup_row0 = 1536; }
            else if (r < 5824) { r -= 5312; K = 1024; N = 2048; src = inp(F, I_WOM) + (size_t)l * 1024 * 2048; dst = (bf16_t*)(F.ws + WS_WOC + l * SZ_WOC); ldd = 2048; dcol0 = 0; is_wo = true; }
            else if (r < 6080) { r -= 5824; K = 512; N = 2048; src = inp(F, I_WON) + (size_t)l * 512 * 2048; dst = (bf16_t*)(F.ws + WS_WOC + l * SZ_WOC); ldd = 2048; dcol0 = 1024; is_wo = true; }
            else if (r < 6336) { r -= 6080; K = 512; N = 2048; src = inp(F, I_WOG) + (size_t)l * 512 * 2048; dst = (bf16_t*)(F.ws + WS_WOC + l * SZ_WOC); ldd = 2048; dcol0 = 1536; is_wo = true; }
            else { r -= 6336; K = 2048; N = 2048; src = inp(F, I_WOUT) + (size_t)l * 2048 * 2048; dst = (bf16_t*)(F.ws + WS_WOUT + l * SZ_WOUT); is_wout = true; }
            const int nkc = K >> 6; cb = r / nkc; kc = r % nkc; sc0 = cb * 64; dbase = cb * 64;
            if (K == 2048 && N == IN_COLS) { const int n0 = cb * 64; sc0 = n0 < 1024 ? n0 : (n0 < P_KR ? n0 + 64 : (n0 < P_KR + 64 ? n0 - P_KR + 1024 : -1));
                if (n0 < P_KR) {
                    cvt_task8(F, src, (size_t)IN_COLS, sc0, kc * 64, (unsigned char*)(F.ws + WS_WIN8 + l * SZ_WIN8), 2048, 0, n0, 64.0f); return; } }
        } else {
            r -= CVT_DENSE;
            const bool isdn = r >= 512 * NEXP; const int e = isdn ? (r - 512 * NEXP) >> 8 : r >> 9, kind = isdn ? 2 : (r >> 8) & 1, q = r & 255;
            if (kind < 2) { unsigned char* d8 = (unsigned char*)(F.ws + WS_WGU + l * SZ_WGU) + ((size_t)e * 1024 + kind * 128) * 2048;
                cvt_task8(F, inp(F, kind ? I_WU : I_WG) + ((size_t)l * NEXP + e) * DM * MOE_H, (size_t)MOE_H, (q >> 5) * 64, (q & 31) * 64, d8, 2048, 1, (q >> 5) * 64, 64.0f);
                return; }
            else { unsigned char* d8 = (unsigned char*)(F.ws + WS_WD + l * SZ_WD) + (size_t)e * 2048 * 512;
                cvt_task8(F, inp(F, I_WDN) + ((size_t)l * NEXP + e) * MOE_H * DM, (size_t)DM, (q >> 3) * 64, (q & 7) * 64, d8, 512, 0, (q >> 3) * 64, 32.0f);
                return; }
        }
        if (wup_row0 >= 0) { cvt_task8(F, src, (size_t)N, sc0, kc * 64, (unsigned char*)(F.ws + WS_WUP + l * SZ_WUP), 512, 0, wup_row0 + dbase, 64.0f, rowgain); return; }
        if (is_wout) { cvt_task8(F, src, (size_t)N, sc0, kc * 64, (unsigned char*)(F.ws + WS_WOUT8 + l * SZ_WOUT8), 2048, 0, dbase, 64.0f);
            if (l != 0) return; }
        if (is_wo) { cvt_task8(F, src, (size_t)N, sc0, kc * 64, (unsigned char*)(F.ws + WS_WOC8 + l * SZ_WOC8) + dcol0, 2048, 0, dbase, 64.0f);
            if (l != 0) return; }
        cvt_task(F, src, (size_t)N, sc0, kc * 64, dst, ldd ? ldd : K, dcol0, dmode, dbase, rowgain);
}
constexpr int CVT_Q_MOE0 = CVT_EXP * NEXP, CVT_Q_L1D = CVT_Q_MOE0 + CVT_DENSE, CVT_Q_ALL = CVT_Q_MOE0 + CVT_LAYER;
constexpr int BG_PER_WAVE = 9;
constexpr int BG_M1 = 12, BG_M1_BLK0 = 176, BG_M1_TASKS = (256 - BG_M1_BLK0) * 8 * BG_M1;
constexpr int BG_M1B = 5, BG_M1B_BLK0 = 112, BG_M1B_TASKS = (256 - BG_M1B_BLK0) * 8 * BG_M1B;
__device__ __forceinline__ void bg_range(const Frame& F, const int qa, const int qb) {
#pragma unroll 1
    for (int q = qa + F.gw; q < qb; q += F.nwt) cvt_do(F, q < CVT_Q_MOE0 ? CVT_DENSE + q : CVT_LAYER + (q - CVT_Q_MOE0));
}
__device__ __forceinline__ void bg_idle(const Frame& F, const int qa, const int idle_rank, const int per_wave = BG_PER_WAVE) {
#pragma unroll 1
    for (int n = 0; n < per_wave; ++n) { const int q = qa + (idle_rank * 8 + F.wave) * per_wave + n; cvt_do(F, q < CVT_Q_MOE0 ? CVT_DENSE + q : CVT_LAYER + (q - CVT_Q_MOE0)); }
}
__device__ __forceinline__ void phase0(const Frame& F0) {
    const Frame F = refresh(F0);
    float* sv = (float*)F.ldsg;
    float* red = (float*)(F.ldsg + 32768);
    { const float* cc = inp(F, I_C); const float* cx_ = inp(F, I_CCTX);
      for (int i = F.tid; i < 3 * DM; i += 512) { const int v = i / DM, k = i % DM; const float c = v < 2 ? cc[v * DM + k] : cx_[k]; sv[i] = siluf_(c); } }
    __syncthreads();
    float* mod = (float*)(F.ws + WS_MOD); const float* adaw = inp(F, I_ADAW); const float* adab = inp(F, I_ADAB);
    for (int task = F.bid; task < 768; task += F.G) {
        const int l = task / 384, n0 = (task % 384) * 32, col = n0 + (F.lane & 31), kpar = F.lane >> 5, kbase = F.wave * 256;
        const float* W = adaw + (size_t)l * DM * 6 * DM + col;
        float a0 = 0.f, a1 = 0.f, a2 = 0.f;
#pragma unroll 1
        for (int kk = 0; kk < 128; kk += 16) {
            float w[16];
#pragma unroll
            for (int u = 0; u < 16; ++u) w[u] = __builtin_nontemporal_load(W + (size_t)(kbase + (kk + u) * 2 + kpar) * (6 * DM));
#pragma unroll
            for (int u = 0; u < 16; ++u) { const int k = kbase + (kk + u) * 2 + kpar; a0 = fmaf(w[u], sv[k], a0); a1 = fmaf(w[u], sv[DM + k], a1); a2 = fmaf(w[u], sv[2 * DM + k], a2); }
        }
        const int slot = F.wave * 2 + kpar;
        red[(0 * 16 + slot) * 32 + (F.lane & 31)] = a0; red[(1 * 16 + slot) * 32 + (F.lane & 31)] = a1; red[(2 * 16 + slot) * 32 + (F.lane & 31)] = a2;
        __syncthreads();
        if (F.tid < 96) { const int v = F.tid / 32, c = F.tid % 32; float s = 0.f;
#pragma unroll
            for (int j = 0; j < 16; ++j) s += red[(v * 16 + j) * 32 + c];
            mod[(size_t)(l * 3 + v) * 6 * DM + n0 + c] = s + adab[l * 6 * DM + n0 + c]; }
        __syncthreads();
    }
    { float2* rope = (float2*)(F.ws + WS_ROPE);
      for (int idx = F.bid * 512 + F.tid; idx < SEQ * 32; idx += F.G * 512) { const int pos = idx >> 5, i = idx & 31, j = i & 15;
          const float inv = powf(10000.0f, -(float)j / 16.0f); const float a = (i < 16 ? (float)(pos >> 6) : (float)(pos & 63)) * inv;
          float s, c; sincosf(a, &s, &c); rope[idx] = make_float2(c, s); } }
    { bf16_t* wr = (bf16_t*)(F.ws + WS_WR); const float* wgrp = inp(F, I_WGRP); const float* wexp = inp(F, I_WEXP);
      for (int idx = F.bid * 512 + F.tid; idx < NLAYER * 48 * DM; idx += F.G * 512) { const int l = idx / (48 * DM), rem = idx % (48 * DM), n = rem / DM, k = rem % DM;
          float v = 0.f; if (n < 4) v = wgrp[((size_t)l * DM + k) * 4 + n]; else if (n < 36) v = wexp[((size_t)l * DM + k) * 32 + (n - 4)];
          wr[idx] = (bf16_t)(cvt_pk_bf16(v, 0.f) & 0xffffu); } }
#pragma unroll 1
    for (int t = F.gw; t < CVT_DENSE; t += F.nwt) cvt_do(F, t);
}

__device__ __forceinline__ void norm_mod_store(const f32x4 (&xv)[8], const float* g, const float* sh, const float* sc, bf16_t* hrow, int lane, unsigned char* h8row = nullptr) {
    float ss = 0.f;
#pragma unroll
    for (int i = 0; i < 8; ++i) ss += xv[i][0] * xv[i][0] + xv[i][1] * xv[i][1] + xv[i][2] * xv[i][2] + xv[i][3] * xv[i][3];
    ss = wave_sum(ss);
    const float r = rsqrtf(ss * (1.0f / DM) + EPS);
#pragma unroll
    for (int i = 0; i < 8; ++i) { const int c = i * 256 + lane * 4;
        const f32x4 gv = *(const f32x4*)(g + c), shv = *(const f32x4*)(sh + c), scv = *(const f32x4*)(sc + c);
        f32x4 h;
#pragma unroll
        for (int j = 0; j < 4; ++j) h[j] = (xv[i][j] * r * gv[j]) * (1.0f + scv[j]) + shv[j];
        u32x2 w; w.x = cvt_pk_bf16(h[0], h[1]); w.y = cvt_pk_bf16(h[2], h[3]); *(u32x2*)(hrow + c) = w;
        if (h8row) *(unsigned*)(h8row + c) = pk4_fp8(h[0], h[1], h[2], h[3]); }
}
constexpr int NTAB_OFF = 65536;
__device__ __forceinline__ LAS float* norm_tables(const Frame& F, const float* g, int l, int ch_sh, int ch_sc) {
    LAS float* tab = (LAS float*)(F.lds + NTAB_OFF);
    const float* ml = (const float*)(F.ws + WS_MOD) + (size_t)l * 3 * 6 * DM;
    __syncthreads();
    for (int i = F.tid; i < 3 * DM / 4; i += 512) { const int v = i / (DM / 4), c = (i % (DM / 4)) * 4;
        const f32x4 gv = *(const f32x4*)(g + c), shv = *(const f32x4*)(ml + (size_t)(v * 6 + ch_sh) * DM + c), scv = *(const f32x4*)(ml + (size_t)(v * 6 + ch_sc) * DM + c);
        *(LAS f32x4*)(tab + v * DM + c) = gv * (1.0f + scv); *(LAS f32x4*)(tab + 3 * DM + v * DM + c) = shv; }
    __syncthreads();
    return tab;
}
__device__ __forceinline__ void norm_mod_store_t(const f32x4 (&xv)[8], const LAS float* tab, int row, bf16_t* hrow, int lane, unsigned char* h8row) {
    const int v = row < TL ? (row >> 12) : 2; const LAS float* gs = tab + v * DM; const LAS float* sh = tab + 3 * DM + v * DM;
    float ss = 0.f;
#pragma unroll
    for (int i = 0; i < 8; ++i) ss += xv[i][0] * xv[i][0] + xv[i][1] * xv[i][1] + xv[i][2] * xv[i][2] + xv[i][3] * xv[i][3];
    ss = wave_sum(ss);
    const float r = rsqrtf(ss * (1.0f / DM) + EPS);
#pragma unroll
    for (int i = 0; i < 8; ++i) { const int c = i * 256 + lane * 4;
        const f32x4 gv = *(const LAS f32x4*)(gs + c), shv = *(const LAS f32x4*)(sh + c);
        f32x4 h;
#pragma unroll
        for (int j = 0; j < 4; ++j) h[j] = (xv[i][j] * r) * gv[j] + shv[j];
        u32x2 w; w.x = cvt_pk_bf16(h[0], h[1]); w.y = cvt_pk_bf16(h[2], h[3]); *(u32x2*)(hrow + c) = w;
        *(unsigned*)(h8row + c) = pk4_fp8(h[0], h[1], h[2], h[3]); }
}
__device__ __forceinline__ const float* mod_ptr(const Frame& F, int l, int row, int chunk) {
    const int v = row < TL ? (row >> 12) : 2;
    return (const float*)(F.ws + WS_MOD) + ((size_t)(l * 3 + v) * 6 + chunk) * DM;
}
__device__ __forceinline__ void phase_norm(const Frame& F0, int l, int which, int nrows) {
    const Frame F = refresh(F0);
    bf16_t* hb = (bf16_t*)(F.ws + WS_HBUF);
    const float* g = inp(F, which ? I_NFFNG : I_NMIXG) + l * DM;
    const float* xin = inp(F, I_X); const float* cin = inp(F, I_CTX);
    const LAS float* tab = norm_tables(F, g, l, which ? 3 : 0, which ? 4 : 1);
    for (int row = F.gw; row < nrows; row += F.nwt) {
        const float* xr = row < TL ? xin + (size_t)row * DM : cin + (size_t)(row - TL) * DM;
        f32x4 xv[8];
#pragma unroll
        for (int i = 0; i < 8; ++i) xv[i] = *(const f32x4*)(xr + i * 256 + F.lane * 4);
        norm_mod_store_t(xv, tab, row, hb + (size_t)row * DM, F.lane, (unsigned char*)(F.ws + WS_HB8) + (size_t)row * DM);
    }
}

__device__ __forceinline__ void unpack8(const u32x4 w, float (&f)[8]) { f[0] = bf_lo(w.x); f[1] = bf_hi(w.x); f[2] = bf_lo(w.y); f[3] = bf_hi(w.y); f[4] = bf_lo(w.z); f[5] = bf_hi(w.z); f[6] = bf_lo(w.w); f[7] = bf_hi(w.w); }
__device__ __forceinline__ u32x4 pack8(const float (&f)[8]) { u32x4 w; w.x = cvt_pk_bf16(f[0], f[1]); w.y = cvt_pk_bf16(f[2], f[3]); w.z = cvt_pk_bf16(f[4], f[5]); w.w = cvt_pk_bf16(f[6], f[7]); return w; }
template <int GS> __device__ __forceinline__ float group_sum(float v) {
#pragma unroll
    for (int o = GS / 2; o > 0; o >>= 1) v += __shfl_xor(v, o);
    return v;
}
__device__ __forceinline__ void rope8(float (&f)[8], const float2* cs, int lane) {
    const int ch = lane & 7; const bool lo = ch < 4; const int i0 = (ch & 3) * 8;
#pragma unroll
    for (int e = 0; e < 8; ++e) { const float other = __shfl_xor(f[e], 4); const float2 c = cs[i0 + e];
        f[e] = lo ? (f[e] * c.x - other * c.y) : (other * c.y + f[e] * c.x); }
}
template <int NT>
__device__ __forceinline__ void small_rows_mma(const bf16_t* A, int lda, const bf16_t* Bt, int row0, int kq, int lane, f32x4 (&acc)[NT]) {
    const bf16_t* ap = A + (size_t)(row0 + (lane & 15)) * lda + kq * 512 + (lane >> 4) * 8;
    const bf16_t* bp = Bt + (size_t)(lane & 15) * DM + kq * 512 + (lane >> 4) * 8;
#pragma unroll
    for (int n = 0; n < NT; ++n) acc[n] = (f32x4){0.f, 0.f, 0.f, 0.f};
#pragma unroll 8
    for (int ks = 0; ks < 16; ++ks) {
        const bf16x8 a = *(const bf16x8*)(ap + ks * 32);
#pragma unroll
        for (int n = 0; n < NT; ++n) { const bf16x8 bb = *(const bf16x8*)(bp + (size_t)n * 16 * DM + ks * 32); acc[n] = __builtin_amdgcn_mfma_f32_16x16x32_bf16(a, bb, acc[n], 0, 0, 0); }
    }
}
template <int NT>
__device__ __forceinline__ void small_rows_mma8(const bf16_t* A, int lda, const bf16_t* Bt, int row0, int k8, int lane, f32x4 (&acc)[2][NT]) {
    const bf16_t* ap = A + (size_t)(row0 + (lane & 15)) * lda + k8 * 256 + (lane >> 4) * 8;
    const bf16_t* bp = Bt + (size_t)(lane & 15) * DM + k8 * 256 + (lane >> 4) * 8;
    bf16x8 a[2][8], b[NT][8];
#pragma unroll
    for (int ks = 0; ks < 8; ++ks) { a[0][ks] = *(const bf16x8*)(ap + ks * 32); a[1][ks] = *(const bf16x8*)(ap + (size_t)16 * lda + ks * 32); }
#pragma unroll
    for (int n = 0; n < NT; ++n)
#pragma unroll
        for (int ks = 0; ks < 8; ++ks) b[n][ks] = *(const bf16x8*)(bp + (size_t)n * 16 * DM + ks * 32);
#pragma unroll
    for (int g = 0; g < 2; ++g)
#pragma unroll
        for (int n = 0; n < NT; ++n) acc[g][n] = (f32x4){0.f, 0.f, 0.f, 0.f};
#pragma unroll
    for (int ks = 0; ks < 8; ++ks)
#pragma unroll
        for (int g = 0; g < 2; ++g)
#pragma unroll
            for (int n = 0; n < NT; ++n) acc[g][n] = __builtin_amdgcn_mfma_f32_16x16x32_bf16(a[g][ks], b[n][ks], acc[g][n], 0, 0, 0);
}
template <int NT>
__device__ __forceinline__ void small_rows_part(float* part, int k8, int lane, const f32x4 (&acc)[2][NT]) {
    float* pp = part + k8 * (32 * NT * 16);
#pragma unroll
    for (int g = 0; g < 2; ++g)
#pragma unroll
        for (int n = 0; n < NT; ++n)
#pragma unroll
            for (int r = 0; r < 4; ++r) pp[(g * 16 + 4 * (lane >> 4) + r) * (NT * 16) + n * 16 + (lane & 15)] = acc[g][n][r];
}
struct Prep1G { const float *mq, *mkv, *naq, *nak, *gq, *gk; };
__device__ __forceinline__ void prep1_row(bf16_t* pr, const u32x4 (&sg)[6], const Prep1G& G, bool lat, const float2* cs, int lane, bool wr_ = true) {
    float f[8];
#pragma unroll
    for (int w = 0; w < 2; ++w) { const float* g = w ? G.nak : G.naq;
        unpack8(sg[2 + w], f); float ss = 0.f;
#pragma unroll
        for (int e = 0; e < 8; ++e) ss += f[e] * f[e];
        ss = group_sum<16>(ss); const float r = rsqrtf(ss * (1.0f / 128) + EPS);
#pragma unroll
        for (int e = 0; e < 8; ++e) f[e] = f[e] * r * g[e];
        if (wr_) *(u32x4*)(pr + (w ? P_NAK : P_NAQ) + lane * 8) = pack8(f); }
    { unpack8(sg[4], f); float ss = 0.f;
#pragma unroll
      for (int e = 0; e < 8; ++e) ss += f[e] * f[e];
      ss = group_sum<8>(ss); const float r = rsqrtf(ss * (1.0f / 64) + EPS);
#pragma unroll
      for (int e = 0; e < 8; ++e) f[e] = f[e] * r * G.gq[e];
      if (lat) rope8(f, cs, lane);
      if (wr_) *(u32x4*)(pr + P_GQ + lane * 8) = pack8(f); }
    { unpack8(sg[5], f); float ss = 0.f;
#pragma unroll
      for (int e = 0; e < 8; ++e) ss += f[e] * f[e];
      ss = group_sum<8>(ss); const float r = rsqrtf(ss * (1.0f / 64) + EPS);
#pragma unroll
      for (int e = 0; e < 8; ++e) f[e] = f[e] * r * G.gk[e];
      if (lat) rope8(f, cs, lane);
      if (wr_ && lane < 16) *(u32x4*)(pr + P_GK + (lane & 15) * 8) = pack8(f); }
}
__device__ __forceinline__ void phase_prep1(const Frame& F0, int l, int dry = 0) {
    const Frame F = refresh(F0);
    bf16_t* proj = (bf16_t*)(F.ws + WS_PROJ); const float2* rope = (const float2*)(F.ws + WS_ROPE);
    const int lane = F.lane;
    { const bf16_t* hb = (const bf16_t*)(F.ws + WS_HBUF); const bf16_t* wk = (const bf16_t*)(F.ws + WS_WIN + l * SZ_WIN) + (size_t)P_KR * DM;
      float* part = (float*)F.ldsg;
      for (int task = F.bid; task < TT / 32; task += F.G) {
          const int row0 = task * 32; f32x4 acc[2][4];
          small_rows_mma8<4>(hb, DM, wk, row0, F.wave, lane, acc);
          small_rows_part<4>(part, F.wave, lane, acc);
          __syncthreads();
          { const int rr = F.tid >> 4, c4 = (F.tid & 15) * 4; const float* q = part + rr * 64 + c4; f32x4 v = *(const f32x4*)q;
#pragma unroll
            for (int k = 1; k < 8; ++k) v += *(const f32x4*)(q + k * 2048);
            u32x2 w; w.x = cvt_pk_bf16(v[0], v[1]); w.y = cvt_pk_bf16(v[2], v[3]);
            *(u32x2*)(proj + (size_t)(row0 + rr) * PROJ_LD + P_KR + c4) = w; }
          __syncthreads();
      } }
    Prep1G G; G.mq = inp(F, I_MQNG) + l * 512 + lane * 8; G.mkv = inp(F, I_MKVNG) + l * 512 + lane * 8;
    G.naq = inp(F, I_NAQN) + l * 128 + (lane & 15) * 8; G.nak = inp(F, I_NAKN) + l * 128 + (lane & 15) * 8;
    G.gq = inp(F, I_GQN) + l * 64 + (lane & 7) * 8; G.gk = inp(F, I_GKN) + l * 64 + (lane & 7) * 8;
    constexpr int NR = 5;
    for (int row = F.gw; row < TT; row += NR * F.nwt) {
        u32x4 sg[NR][6];
#pragma unroll
        for (int j = 0; j < NR; ++j) { const int rj = row + j * F.nwt < TT ? row + j * F.nwt : row; const bf16_t* pr = proj + (size_t)rj * PROJ_LD;
            sg[j][0] = (u32x4){0u, 0u, 0u, 0u}; sg[j][1] = sg[j][0]; sg[j][2] = *(const u32x4*)(pr + P_NAQ + lane * 8);
            sg[j][3] = *(const u32x4*)(pr + P_NAK + lane * 8); sg[j][4] = *(const u32x4*)(pr + P_GQ + lane * 8); sg[j][5] = *(const u32x4*)(pr + P_GK + (lane & 15) * 8); }
#pragma unroll
        for (int j = 0; j < NR; ++j) { const int rj = row + j * F.nwt;
            if (rj < TT) prep1_row(proj + (size_t)rj * PROJ_LD, sg[j], G, rj < TL, rope + (size_t)(rj & (SEQ - 1)) * 32, lane, !dry); }
    }
}

template <class Fin>
__device__ __forceinline__ void small_gemm_rows(const Frame& F, const bf16_t* A, int lda, const bf16_t* Bt, int row_begin, int nrows, int ncols, const Fin& fin) {
    float* part = (float*)F.ldsg;
    const int lane = F.lane, ncb = ncols >> 6;
    for (int task = F.bid; task < (nrows >> 5) * ncb; task += F.G) {
        const int rb = task / ncb, cbk = task - rb * ncb, row0 = row_begin + rb * 32, col0 = cbk * 64;
        f32x4 acc[2][4];
        small_rows_mma8<4>(A, lda, Bt + (size_t)col0 * DM, row0, F.wave, lane, acc);
        small_rows_part<4>(part, F.wave, lane, acc);
        __syncthreads();
        { const int rr = F.tid >> 4, c4 = (F.tid & 15) * 4; const float* q = part + rr * 64 + c4;
          fin(row0 + rr, col0 + c4, *(const f32x4*)q + *(const f32x4*)(q + 2048), *(const f32x4*)(q + 2 * 2048) + *(const f32x4*)(q + 3 * 2048),
              *(const f32x4*)(q + 4 * 2048) + *(const f32x4*)(q + 5 * 2048), *(const f32x4*)(q + 6 * 2048) + *(const f32x4*)(q + 7 * 2048)); }
        __syncthreads();
    }
}

__device__ __forceinline__ void prep2_row(bf16_t* q, unsigned char* k, const u32x4 (&sg)[6], const float* gq, const float* gk, bool lat, const float2* cs, int lane, bool wr_ = true) {
    const int ch = lane & 7;
    float f0[8], f1[8], f2[8];
    { unpack8(sg[3], f0); unpack8(sg[4], f1); unpack8(sg[5], f2);
      float ss = 0.f;
#pragma unroll
      for (int e = 0; e < 8; ++e) ss += f0[e] * f0[e] + f1[e] * f1[e] + f2[e] * f2[e];
      ss = group_sum<8>(ss); const float r = rsqrtf(ss * (1.0f / 192) + EPS);
#pragma unroll
      for (int e = 0; e < 8; ++e) { f0[e] *= r * gk[ch * 8 + e]; f1[e] *= r * gk[64 + ch * 8 + e]; f2[e] *= r * gk[128 + ch * 8 + e]; }
      if (lat) rope8(f2, cs, lane);
      if (wr_) {
          u32x2 w; w.x = pk4_fp8(f0[0], f0[1], f0[2], f0[3]); w.y = pk4_fp8(f0[4], f0[5], f0[6], f0[7]); *(u32x2*)(k) = w;
          w.x = pk4_fp8(f1[0], f1[1], f1[2], f1[3]); w.y = pk4_fp8(f1[4], f1[5], f1[6], f1[7]); *(u32x2*)(k + 64) = w;
          w.x = pk4_fp8(f2[0], f2[1], f2[2], f2[3]); w.y = pk4_fp8(f2[4], f2[5], f2[6], f2[7]); *(u32x2*)(k + 128) = w; } }
}
__device__ __forceinline__ void phase_prep2(const Frame& F0, int l, int dry = 0) {
    const Frame F = refresh(F0);
    const int lane = F.lane, h = lane >> 3, ch = lane & 7;
    bf16_t* qraw = (bf16_t*)(F.ws + WS_QRAW); const bf16_t* kvraw = (const bf16_t*)(F.ws + WS_KVRAW); unsigned char* km = (unsigned char*)(F.ws + WS_KM);
    const bf16_t* proj = (const bf16_t*)(F.ws + WS_PROJ); const float2* rope = (const float2*)(F.ws + WS_ROPE);
    const float* gq = inp(F, I_MQN) + l * 192; const float* gk = inp(F, I_MKN) + l * 192;
    constexpr int NR = 5;
    for (int row = F.gw; row < TT; row += NR * F.nwt) {
        u32x4 sg[NR][6];
#pragma unroll
        for (int j = 0; j < NR; ++j) { const int rj = row + j * F.nwt < TT ? row + j * F.nwt : row;
            const bf16_t* q = qraw + (size_t)rj * 1536 + h * 192 + ch * 8; const bf16_t* kv = kvraw + (size_t)rj * 2048 + h * 256 + ch * 8;
            sg[j][0] = (u32x4){0u, 0u, 0u, 0u}; sg[j][1] = sg[j][0]; sg[j][2] = sg[j][0]; (void)q;
            sg[j][3] = *(const u32x4*)(kv); sg[j][4] = *(const u32x4*)(kv + 64); sg[j][5] = *(const u32x4*)(proj + (size_t)rj * PROJ_LD + P_KR + ch * 8); }
#pragma unroll
        for (int j = 0; j < NR; ++j) { const int rj = row + j * F.nwt;
            if (rj < TT) prep2_row(qraw + (size_t)rj * 1536 + h * 192 + ch * 8, km + (size_t)rj * 1536 + h * 192 + ch * 8, sg[j], gq, gk, rj < TL, rope + (size_t)(rj & (SEQ - 1)) * 32, lane, !dry); }
    }
    { LAS unsigned char* T = F.lds + F.wave * 8192; unsigned char* vt8 = (unsigned char*)(F.ws + WS_VT8);
      const int k5 = lane & 31, p = ((k5 >> 2) & 1) * 32 + (lane >> 5) * 16 + (k5 & 3) + 4 * (k5 >> 3);
      for (int task = F.gw; task < (TT / 64) * 8; task += F.nwt) {
          const bf16_t* src = kvraw + (size_t)((task >> 3) * 64 + lane) * 2048 + (task & 7) * 256 + 128;
          u32x4 w[16];
#pragma unroll
          for (int i = 0; i < 16; ++i) w[i] = *(const u32x4*)(src + i * 8);
#pragma unroll
          for (int i = 0; i < 16; ++i) { float f[8]; unpack8(w[i], f); const unsigned a = pk4_fp8(f[0], f[1], f[2], f[3]), b = pk4_fp8(f[4], f[5], f[6], f[7]);
#pragma unroll
              for (int e = 0; e < 4; ++e) { T[(i * 8 + e) * 64 + p] = (unsigned char)((a >> (8 * e)) & 0xffu); T[(i * 8 + 4 + e) * 64 + p] = (unsigned char)((b >> (8 * e)) & 0xffu); } }
          asm volatile("s_waitcnt lgkmcnt(0)" ::: "memory");
          if (!dry) {
#pragma unroll
              for (int c = 0; c < 8; ++c) { const u32x4 v = *(const LAS u32x4*)(T + (c * 64 + lane) * 16); *(u32x4*)(vt8 + (size_t)task * 8192 + (c * 64 + lane) * 16) = v; } }
          asm volatile("s_waitcnt lgkmcnt(0)" ::: "memory");
      } }
}

__device__ __forceinline__ void phase_attn(const Frame& F0, int l) {
    const Frame F = refresh(F0);
    char* lds = F.ldsg;
    const bf16_t* proj = (const bf16_t*)(F.ws + WS_PROJ); const bf16_t* qm = (const bf16_t*)(F.ws + WS_QRAW); const unsigned char* km = (const unsigned char*)(F.ws + WS_KM);
    const bf16_t* kvraw = (const bf16_t*)(F.ws + WS_KVRAW); bf16_t* ocat = (bf16_t*)(F.ws + WS_OCAT);
    unsigned char* ocat8 = (unsigned char*)(F.ws + WS_OCAT);
    const float* mqg = inp(F, I_MQN) + l * 192; const float2* ropet = (const float2*)(F.ws + WS_ROPE);
    const bool ctxq = (l == 0); const float* sinkp = inp(F, I_SINK) + l * 8; const float* rpbp = inp(F, I_RPB) + (size_t)l * 4 * 465;
    const int n_mla = 256 + (ctxq ? 16 : 0);
    for (int rp_ = 0; rp_ < REPS(16); ++rp_)
    for (int it = F.bid; it < n_mla; it += F.G) {
        AttnCx cx{}; int b, h;
        if (it < 256) { const int ix = (it & 7) * 32 + (it >> 3);
            b = ix >> 7; h = (ix >> 4) & 7; const int qb = ix & 15; cx.qtok0 = b * SEQ + qb * 256; cx.nloc = 64; cx.nt = 68; cx.ktok_loc0 = b * SEQ; }
        else { const int j = it - 256; b = j >> 3; h = j & 7; cx.qtok0 = TL + b * CL; cx.nloc = 0; cx.nt = 4; cx.ktok_loc0 = 0; }
        cx.ktok_ctx0 = TL + b * CL; cx.qmap = 0;
        cx.mq_gain = mqg; cx.mq_rope = ropet;
        cx.Qb = qm + h * 192; cx.ldq = 1536; cx.qwoff = 0; cx.Kb = (const bf16_t*)(km + h * 192); cx.ldk = 1536;     cx.Vb = (const bf16_t*)((const unsigned char*)(F.ws + WS_VT8) + h * 8192); cx.ldv = 0;
        cx.Ob = ocat + h * 128; cx.Ob8 = it < 256 ? ocat8 + h * 128 : nullptr; cx.ldo = DM; cx.owoff = 0; cx.scale_l2 = 0.07216878364870322f * LOG2E;
        attn_item<192, 128, 0>(lds, cx, F.wave);
    }
    const int n_gq = 256 + (ctxq ? 16 : 0);
    for (int rp_ = 0; rp_ < REPS(17); ++rp_)
    for (int it = F.bid; it < n_gq; it += F.G) {
        AttnCx cx{}; int b, kvh;
        if (it < 256) { const int ix = (it & 7) * 32 + (it >> 3); b = ix >> 7; kvh = (ix >> 6) & 1; const int pb = ix & 63; const int t0 = pb - 2 < 0 ? 0 : pb - 2, t1 = pb + 2 > 63 ? 63 : pb + 2;
            cx.qtok0 = b * SEQ + pb * 64; cx.nloc = t1 - t0 + 1; cx.nt = cx.nloc + 4; cx.ktok_loc0 = b * SEQ + t0 * 64; cx.gq_pos0 = pb * 64; cx.gq_kpos0 = t0 * 64; cx.local = 1; }
        else { const int j = it - 256; b = j >> 3; kvh = (j >> 2) & 1; const int part = j & 3; cx.qtok0 = TL + b * CL + part * 64; cx.nloc = 0; cx.nt = 4; cx.local = 0; }
        cx.ktok_ctx0 = TL + b * CL; cx.qmap = 2;
        cx.Qb = proj + P_GQ + kvh * 256; cx.ldq = PROJ_LD; cx.qwoff = 64; cx.Kb = proj + P_GK + kvh * 64; cx.ldk = PROJ_LD; cx.Vb = proj + P_GV + kvh * 64; cx.ldv = PROJ_LD;
        cx.Ob = ocat + 1536 + kvh * 256; cx.Ob8 = it < 256 ? ocat8 + 1536 + kvh * 256 : nullptr; cx.ldo = DM; cx.owoff = 64; cx.scale_l2 = 0.125f * LOG2E; cx.sink = sinkp + kvh * 4;
        attn_item<64, 64, 2>(lds, cx, F.wave);
    }
    const int n_na = 128 + (ctxq ? 8 : 0);
    float* biasl = (float*)(lds + 100352);
    for (int rp_ = 0; rp_ < REPS(18); ++rp_)
    for (int it = (F.G - 1 - F.bid); it < n_na; it += F.G) {
        AttnCx cx{}; int b, h;
        if (it < 128) { const int ix = (it & 7) * 16 + (it >> 3); b = ix >> 6; h = (ix >> 4) & 3; const int rg = ix & 15; const int kr0 = min(max(rg * 4 - 4, 0), 56), kr1 = min(max(rg * 4 + 3 - 4, 0), 56) + 7;
            cx.qtok0 = b * SEQ + rg * 256; cx.qmap = 1; cx.nloc = kr1 - kr0 + 1; cx.nt = cx.nloc + 4; cx.ktok_loc0 = b * SEQ + kr0 * 64; cx.na_r0 = rg * 4; cx.na_kr0 = kr0; }
        else { const int j = it - 128; b = j >> 2; h = j & 3; cx.qtok0 = TL + b * CL; cx.qmap = 0; cx.nloc = 0; cx.nt = 4; }
        cx.ktok_ctx0 = TL + b * CL;
        for (int i = F.tid; i < 15 * 31; i += 512) biasl[i] = rpbp[h * 465 + i] * LOG2E;
        cx.bias = biasl;
        cx.Qb = proj + P_NAQ + h * 128; cx.ldq = PROJ_LD; cx.qwoff = 0; cx.Kb = proj + P_NAK + h * 128; cx.ldk = PROJ_LD; cx.Vb = proj + P_NAV + h * 128; cx.ldv = PROJ_LD;
        cx.Ob = ocat + 1024 + h * 128; cx.Ob8 = it < 128 ? ocat8 + 1024 + h * 128 : nullptr; cx.ldo = DM; cx.owoff = 0; cx.scale_l2 = 0.08838834764831845f * LOG2E;
        attn_item<128, 128, 1>(lds, cx, F.wave);
    }
    if ((F.G - 1 - F.bid) >= n_na) bg_idle(F, l == 0 ? 0 : CVT_Q_L1D, F.bid);
}

__device__ __forceinline__ void phase_router(const Frame& F0, int l, int nrows, int dry = 0) {
    const Frame F = refresh(F0);
    const int lane = F.lane, grp = F.wave >> 2, kq = F.wave & 3;
    const bf16_t* hb = (const bf16_t*)(F.ws + WS_HBUF); const bf16_t* wr = (const bf16_t*)(F.ws + WS_WR + l * SZ_WR);
    float* part = (float*)F.ldsg;
    const float* bgrp = inp(F, I_BGRP) + l * 4; const float* bexp = inp(F, I_BEXP) + l * 32;
    unsigned* cnt = (unsigned*)(F.ws + WS_CTL) + CW_CNT + l * 32;
    int* tok_e = (int*)(F.ws + WS_TOK); int* tok_pos = (int*)(F.ws + WS_TOK + SZ_TOK1); float* tok_w = (float*)(F.ws + WS_TOK + 2 * SZ_TOK1); int* rlist = (int*)(F.ws + WS_RLIST);
    for (int task = F.bid; task < nrows / 32; task += F.G) {
        const int row0 = task * 32 + grp * 16; f32x4 acc[3];
        small_rows_mma<3>(hb, DM, wr, row0, kq, lane, acc);
        float* pp = part + (grp * 4 + kq) * 768;
#pragma unroll
        for (int n = 0; n < 3; ++n)
#pragma unroll
            for (int r = 0; r < 4; ++r) pp[(4 * (lane >> 4) + r) * 48 + n * 16 + (lane & 15)] = acc[n][r];
        __syncthreads();
        if (kq == 0 && lane < 16 && !dry) {
            const float* L = part + grp * 3072 + lane * 48; const int tok = row0 + lane;
#define LG(j) (L[(j)] + L[768 + (j)] + L[1536 + (j)] + L[2304 + (j)])
            float gl[4]; int gi = 0; float gmax;
#pragma unroll
            for (int g = 0; g < 4; ++g) gl[g] = LG(g) + bgrp[g];
            gmax = gl[0];
#pragma unroll
            for (int g = 1; g < 4; ++g) if (gl[g] > gmax) { gmax = gl[g]; gi = g; }
            float gs = 0.f;
#pragma unroll
            for (int g = 0; g < 4; ++g) gs += __expf(gl[g] - gmax);
            const float gw = 1.0f / gs;
            float el[8];
#pragma unroll
            for (int j = 0; j < 8; ++j) el[j] = LG(4 + gi * 8 + j) + bexp[gi * 8 + j];
#undef LG
            int i1 = 0; float l1 = el[0];
#pragma unroll
            for (int j = 1; j < 8; ++j) if (el[j] > l1) { l1 = el[j]; i1 = j; }
            int i2 = -1; float l2 = -INFINITY;
#pragma unroll
            for (int j = 0; j < 8; ++j) if (j != i1 && el[j] > l2) { l2 = el[j]; i2 = j; }
            const float e2 = __expf(l2 - l1); const float w1 = gw / (1.0f + e2), w2 = gw * e2 / (1.0f + e2);
            const int e_1 = gi * 8 + i1, e_2 = gi * 8 + i2;
            const unsigned p1 = atomicAdd(&cnt[e_1], 1u), p2 = atomicAdd(&cnt[e_2], 1u);
            tok_e[tok * 2] = e_1; tok_e[tok * 2 + 1] = e_2; tok_pos[tok * 2] = (int)p1; tok_pos[tok * 2 + 1] = (int)p2; tok_w[tok * 2] = w1; tok_w[tok * 2 + 1] = w2;
            rlist[(size_t)e_1 * TT + p1] = tok; rlist[(size_t)e_2 * TT + p2] = tok;
        }
        __syncthreads();
    }
}
__device__ __forceinline__ void phase_n2_router(const Frame& F0, int l, int nrows, int dry = 0) {
    const Frame F = refresh(F0);
    const int lane = F.lane;
    bf16_t* hbw = (bf16_t*)(F.ws + WS_HBUF); const bf16_t* hb = hbw; unsigned char* hb8 = (unsigned char*)(F.ws + WS_HB8); const bf16_t* wr = (const bf16_t*)(F.ws + WS_WR + l * SZ_WR);
    const float* gn = inp(F, I_NFFNG) + l * DM; const bf16_t* xmid = (const bf16_t*)(F.ws + WS_XMID);
    float* part = (float*)F.ldsg;
    const float* bgrp = inp(F, I_BGRP) + l * 4; const float* bexp = inp(F, I_BEXP) + l * 32;
    unsigned* cnt = (unsigned*)(F.ws + WS_CTL) + CW_CNT + l * 32;
    int* tok_e = (int*)(F.ws + WS_TOK); int* tok_pos = (int*)(F.ws + WS_TOK + SZ_TOK1); float* tok_w = (float*)(F.ws + WS_TOK + 2 * SZ_TOK1); int* rlist = (int*)(F.ws + WS_RLIST);
    const LAS float* tab = norm_tables(F, gn, l, 3, 4);
    for (int task = F.bid; task < nrows / 32; task += F.G) {
#pragma unroll 1
        for (int rr = 0; rr < 4; rr += 2) {
            const int r0 = task * 32 + F.wave * 4 + rr, r1 = r0 + 1;
            f32x4 xa[8], xb[8];
#pragma unroll
            for (int i = 0; i < 8; ++i) { const u32x2 a = *(const u32x2*)(xmid + (size_t)r0 * DM + i * 256 + lane * 4), b = *(const u32x2*)(xmid + (size_t)r1 * DM + i * 256 + lane * 4);
                xa[i] = (f32x4){bf_lo(a.x), bf_hi(a.x), bf_lo(a.y), bf_hi(a.y)}; xb[i] = (f32x4){bf_lo(b.x), bf_hi(b.x), bf_lo(b.y), bf_hi(b.y)}; }
            norm_mod_store_t(xa, tab, r0, hbw + (size_t)r0 * DM, lane, hb8 + (size_t)r0 * DM);
            norm_mod_store_t(xb, tab, r1, hbw + (size_t)r1 * DM, lane, hb8 + (size_t)r1 * DM);
        }
        asm volatile("s_waitcnt vmcnt(0)" ::: "memory");
        __syncthreads();
        const int row0 = task * 32; f32x4 acc[2][3];
        small_rows_mma8<3>(hb, DM, wr, row0, F.wave, lane, acc);
        small_rows_part<3>(part, F.wave, lane, acc);
        __syncthreads();
        if (F.tid < 32 && !dry) {
            const float* L = part + F.tid * 48; const int tok = row0 + F.tid;
#define LG(j) (((L[(j)] + L[1536 + (j)]) + (L[2 * 1536 + (j)] + L[3 * 1536 + (j)])) + ((L[4 * 1536 + (j)] + L[5 * 1536 + (j)]) + (L[6 * 1536 + (j)] + L[7 * 1536 + (j)])))
            float gl[4]; int gi = 0; float gmax;
#pragma unroll
            for (int g = 0; g < 4; ++g) gl[g] = LG(g) + bgrp[g];
            gmax = gl[0];
#pragma unroll
            for (int g = 1; g < 4; ++g) if (gl[g] > gmax) { gmax = gl[g]; gi = g; }
            float gs = 0.f;
#pragma unroll
            for (int g = 0; g < 4; ++g) gs += __expf(gl[g] - gmax);
            const float gw = 1.0f / gs;
            float el[8];
#pragma unroll
            for (int j = 0; j < 8; ++j) el[j] = LG(4 + gi * 8 + j) + bexp[gi * 8 + j];
#undef LG
            int i1 = 0; float l1 = el[0];
#pragma unroll
            for (int j = 1; j < 8; ++j) if (el[j] > l1) { l1 = el[j]; i1 = j; }
            int i2 = -1; float l2 = -INFINITY;
#pragma unroll
            for (int j = 0; j < 8; ++j) if (j != i1 && el[j] > l2) { l2 = el[j]; i2 = j; }
            const float e2 = __expf(l2 - l1); const float w1 = gw / (1.0f + e2), w2 = gw * e2 / (1.0f + e2);
            const int e_1 = gi * 8 + i1, e_2 = gi * 8 + i2;
            const unsigned p1 = atomicAdd(&cnt[e_1], 1u), p2 = atomicAdd(&cnt[e_2], 1u);
            tok_e[tok * 2] = e_1; tok_e[tok * 2 + 1] = e_2; tok_pos[tok * 2] = (int)p1; tok_pos[tok * 2 + 1] = (int)p2; tok_w[tok * 2] = w1; tok_w[tok * 2 + 1] = w2;
            rlist[(size_t)e_1 * TT + p1] = tok; rlist[(size_t)e_2 * TT + p2] = tok;
        }
        __syncthreads();
    }
    { const int n_na = 128 + (l == 0 ? 8 : 0), n_idle = F.G - n_na > 0 ? F.G - n_na : 0;
      const int taken = n_idle * 8 * BG_PER_WAVE + ((l == 1 && F.G == 256) ? BG_M1_TASKS : 0);
      bg_range(F, (l == 0 ? 0 : CVT_Q_L1D) + taken, l == 0 ? CVT_Q_MOE0 : CVT_Q_ALL - (F.G == 256 ? BG_M1B_TASKS : 0)); }
    __syncthreads();
    if (F.wave == 0 && !dry) {
        unsigned ticket = 0u;
        if (lane == 0) { unsigned* done = (unsigned*)(F.ws + WS_CTL) + CW_DONE + l; ticket = __hip_atomic_fetch_add(done, 1u, __ATOMIC_RELAXED, __HIP_MEMORY_SCOPE_AGENT); }
        ticket = __shfl(ticket, 0);
        if (ticket == (unsigned)F.G - 1u) {
            int* tg = (int*)(F.ws + WS_CTL) + CW_TILE + l * 384;
            const int e = lane & 31; const int c = (int)__hip_atomic_load(&cnt[e], __ATOMIC_RELAXED, __HIP_MEMORY_SCOPE_AGENT); const int tl = (c + 255) >> 8;
            int inc = tl;
#pragma unroll
            for (int d = 1; d < 32; d <<= 1) { const int up = __shfl_up(inc, d, 32); if (e >= d) inc += up; }
            const int nt0 = inc - tl;
            if (lane < 32) { tg[320 + e] = nt0 * 256;
                for (int j = 0; j < tl; ++j) { tg[nt0 + j] = e; tg[160 + nt0 + j] = j; }
                if (e == NEXP - 1) { tg[320 + NEXP] = inc * 256; tg[128] = inc; } }
        }
    }
}
__device__ __forceinline__ void phase_combine(const Frame& F0, int l, int nrows) {
    const Frame F = refresh(F0);
    const bf16_t* y2 = (const bf16_t*)(F.ws + WS_Y2S); const bf16_t* xmid = (const bf16_t*)(F.ws + WS_XMID);
    const int* tok_e = (const int*)(F.ws + WS_TOK); const int* tok_pos = (const int*)(F.ws + WS_TOK + SZ_TOK1); const float* tok_w = (const float*)(F.ws + WS_TOK + 2 * SZ_TOK1);
    LAS int* offs = (LAS int*)(F.lds + MISC_OFF + 64);
    __syncthreads(); if (F.tid <= NEXP) offs[F.tid] = ((const int*)(F.ws + WS_CTL) + CW_TILE + l * 384)[320 + F.tid]; __syncthreads();
    bf16_t* hb = (bf16_t*)(F.ws + WS_HBUF); float* outp = (float*)inp(F, 32); const float* g_n1 = inp(F, I_NMIXG) + DM;
    const LAS float* tab = nullptr; if (l == 0) tab = norm_tables(F, g_n1, 1, 0, 1);
    for (int row = F.gw; row < nrows; row += F.nwt) {
        const int d0 = offs[tok_e[row * 2]] + tok_pos[row * 2], d1 = offs[tok_e[row * 2 + 1]] + tok_pos[row * 2 + 1]; const float w0 = tok_w[row * 2], w1 = tok_w[row * 2 + 1];
        const float* g2 = mod_ptr(F, l, row, 5);
        const bf16_t* ya = y2 + (size_t)d0 * DM; const bf16_t* yb = y2 + (size_t)d1 * DM;
        f32x4 xv[8];
#pragma unroll
        for (int i = 0; i < 8; ++i) { const int c = i * 256 + F.lane * 4;
            const u32x2 xw = __builtin_nontemporal_load((const u32x2*)(xmid + (size_t)row * DM + c)); const f32x4 x = {bf_lo(xw.x), bf_hi(xw.x), bf_lo(xw.y), bf_hi(xw.y)}; const f32x4 g = *(const f32x4*)(g2 + c);
            const u32x2 a = __builtin_nontemporal_load((const u32x2*)(ya + c)), b = __builtin_nontemporal_load((const u32x2*)(yb + c));
            f32x4 m; m[0] = w0 * bf_lo(a.x) + w1 * bf_lo(b.x); m[1] = w0 * bf_hi(a.x) + w1 * bf_hi(b.x); m[2] = w0 * bf_lo(a.y) + w1 * bf_lo(b.y); m[3] = w0 * bf_hi(a.y) + w1 * bf_hi(b.y);
            xv[i] = x + g * m; }
        if (l == 1) { float* dst = outp + (size_t)row * DM;
#pragma unroll
            for (int i = 0; i < 8; ++i) __builtin_nontemporal_store(xv[i], (f32x4*)(dst + i * 256 + F.lane * 4)); }
        else { bf16_t* dst = (bf16_t*)(F.ws + WS_XL1) + (size_t)row * DM;
#pragma unroll
            for (int i = 0; i < 8; ++i) { u32x2 w; w.x = cvt_pk_bf16(xv[i][0], xv[i][1]); w.y = cvt_pk_bf16(xv[i][2], xv[i][3]); *(u32x2*)(dst + i * 256 + F.lane * 4) = w; } }
        if (l == 0) norm_mod_store_t(xv, tab, row, hb + (size_t)row * DM, F.lane, (unsigned char*)(F.ws + WS_HB8) + (size_t)row * DM);
    }
    if (l == 0) { __syncthreads();
        bg_range(F, CVT_Q_MOE0, CVT_Q_L1D); }
}

#ifdef ONLY_PH
#define IN(k) (((k) < 2 ? (k) : 2 + ((k) - 2) % 13) == ONLY_PH && lo <= (k) && (k) < hi)
#else
#define IN(k) (lo <= (k) && (k) < hi)
#endif
#define SEAM(k) do { if (IN((k) + 1) || rep_ + 1 < REPS(2 + (k) - pb)) xcd_barrier(bar); } while (0)
template <int l>
__device__ __forceinline__ void layer_body(const Frame& F, const int lo, const int hi, const XcdBarrier& bar) {
        const int pb = 2 + 13 * l;
        const int mrows = l == 0 ? TT : TL;
        const Frame FK = F;
#define GEMM_SITE() const Frame F = refresh(FK); const bf16_t* hb = (const bf16_t*)(F.ws + WS_HBUF); bf16_t* proj = (bf16_t*)(F.ws + WS_PROJ); (void)hb; (void)proj
        if (IN(pb + 0)) for (int rep_ = 0; rep_ < REPS(2 + 0); ++rep_) {
            GEMM_SITE();
            {
              pg8::SchedGrid S; S.init(TT, P_KR, F.G, F.bid, DM, DM); S.lda2 = (unsigned)DM; S.ldb2 = (unsigned)DM;
              EpiBf16 E{proj, PROJ_LD, 13, 37, 1 << 30, nullptr, 0, (float*)(F.ws + WS_SSQ) + (size_t)l * TT * 16, 4, (unsigned char*)(F.ws + WS_CQ8), 1.0f, (unsigned char*)(F.ws + WS_GT8), nullptr, 1.0f / 64};
              pg8::gemm_phase<EpiBf16, pg8::SchedGrid, DM, DM, DM, true>(F.lds, (const bf16_t*)(F.ws + WS_HB8), (const bf16_t*)(F.ws + WS_WIN8 + l * SZ_WIN8), S, E, F.wave); }
            SEAM(pb + 0); }
        if (IN(pb + 1)) {
            { GEMM_SITE();
              pg8::SchedGrid S; S.init(TT, 3584, F.G, F.bid, 1024, 512); S.lda2 = 1024u; S.ldb2 = 512u; S.split_pn = 6; S.aextra_lo = 0u; S.aextra_hi = 512u;
              EpiBf16 E{(bf16_t*)(F.ws + WS_QRAW), 1536, 0, 0, 6, (bf16_t*)(F.ws + WS_KVRAW), 2048, nullptr, 0, nullptr, 1.0f / 64, nullptr, (const float*)(F.ws + WS_SSQ) + (size_t)l * TT * 16, 1.0f / 512};
              pg8::gemm_phase<EpiBf16, pg8::SchedGrid, 512, 1024, 512, true>(F.lds, (const bf16_t*)(F.ws + WS_CQ8), (const bf16_t*)(F.ws + WS_WUP + l * SZ_WUP), S, E, F.wave); }
            phase_prep1(F, l, 0);
            if (IN(pb + 3)) xcd_barrier(bar); }
        if (IN(pb + 3)) for (int rep_ = 0; rep_ < REPS(2 + 3); ++rep_) { phase_prep2(F, l, ({ int d_ = (REPS(2 + 3) == 2 && rep_ == 0) ? 1 : 0; asm volatile("" : "+s"(d_)); d_; })); SEAM(pb + 3); }
        if (IN(pb + 4)) for (int rep_ = 0; rep_ < REPS(2 + 4); ++rep_) { phase_attn(F, l); SEAM(pb + 4); }
        if (IN(pb + 5)) for (int rep_ = 0; rep_ < REPS(2 + 5); ++rep_) {
            GEMM_SITE();
            const bf16_t* ocat = (const bf16_t*)(F.ws + WS_OCAT); bf16_t* y = (bf16_t*)(F.ws + WS_Y);
            pg8::SchedGrid S; S.init(TL, DM, F.G, F.bid, DM, DM); S.lda2 = (unsigned)DM; S.ldb2 = (unsigned)DM;
            EpiMerge E{(const unsigned char*)(F.ws + WS_GT8), 0, y, (unsigned char*)(F.ws + WS_Y8), 1.0f / 64};
            pg8::gemm_phase<EpiMerge, pg8::SchedGrid, DM, DM, DM, true>(F.lds, ocat, (const bf16_t*)(F.ws + WS_WOC8 + l * SZ_WOC8), S, E, F.wave);
            if (l == 0) {
                small_gemm_rows(F, ocat, DM, (const bf16_t*)(F.ws + WS_WOC + l * SZ_WOC), TL, TC, DM, [&](int r, int c, f32x4 p0, f32x4 p1, f32x4 p2, f32x4 p3) {
                    const bf16_t* gp = proj + (size_t)r * PROJ_LD + c;
                    const u32x2 a = *(const u32x2*)(gp + P_GA), b = *(const u32x2*)(gp + P_GB), cc = *(const u32x2*)(gp + P_GC);
                    const f32x4 pa = p0 + p1; f32x4 v;
                    v[0] = bf_lo(a.x) * pa[0] + bf_lo(b.x) * p2[0] + bf_lo(cc.x) * p3[0]; v[1] = bf_hi(a.x) * pa[1] + bf_hi(b.x) * p2[1] + bf_hi(cc.x) * p3[1];
                    v[2] = bf_lo(a.y) * pa[2] + bf_lo(b.y) * p2[2] + bf_lo(cc.y) * p3[2]; v[3] = bf_hi(a.y) * pa[3] + bf_hi(b.y) * p2[3] + bf_hi(cc.y) * p3[3];
                    u32x2 w; w.x = cvt_pk_bf16(v[0], v[1]); w.y = cvt_pk_bf16(v[2], v[3]); *(u32x2*)(y + (size_t)r * DM + c) = w; });
            }
            SEAM(pb + 5); }
        if (IN(pb + 6)) for (int rep_ = 0; rep_ < REPS(2 + 6); ++rep_) {
            GEMM_SITE();
            pg8::SchedGrid S; S.init(TL, DM, F.G, F.bid, DM, DM); S.lda2 = (unsigned)DM; S.ldb2 = (unsigned)DM;
            EpiOut<l != 0> E{l == 0 ? (const void*)inp(F, I_X) : (const void*)(F.ws + WS_XL1), l == 0 ? (const void*)inp(F, I_CTX) : (const void*)((const bf16_t*)(F.ws + WS_XL1) + (size_t)TL * DM),
                     (const float*)(F.ws + WS_MOD) + (size_t)l * 3 * 6 * DM, (bf16_t*)(F.ws + WS_XMID), 1.0f / 1024};
            pg8::gemm_phase<EpiOut<l != 0>, pg8::SchedGrid, DM, DM, DM, true>(F.lds, (const bf16_t*)(F.ws + WS_Y8), (const bf16_t*)(F.ws + WS_WOUT8 + l * SZ_WOUT8), S, E, F.wave);
            if (l == 0) {
                const float* cin = inp(F, I_CTX); const float* g1c = (const float*)(F.ws + WS_MOD) + (size_t)(2 * 6 + 2) * DM; bf16_t* xm = (bf16_t*)(F.ws + WS_XMID);
                small_gemm_rows(F, (const bf16_t*)(F.ws + WS_Y), DM, (const bf16_t*)(F.ws + WS_WOUT + l * SZ_WOUT), TL, TC, DM, [&](int r, int c, f32x4 p0, f32x4 p1, f32x4 p2, f32x4 p3) {
                    const f32x4 v = (p0 + p1) + (p2 + p3);
                    const f32x4 xn = *(const f32x4*)(cin + (size_t)(r - TL) * DM + c) + *(const f32x4*)(g1c + c) * v;
                    u32x2 w; w.x = cvt_pk_bf16(xn[0], xn[1]); w.y = cvt_pk_bf16(xn[2], xn[3]); *(u32x2*)(xm + (size_t)r * DM + c) = w; });
            }
            SEAM(pb + 6); }
        if (IN(pb + 7)) for (int rep_ = 0; rep_ < REPS(2 + 7); ++rep_) { phase_n2_router(F, l, mrows, ({ int d_ = (REPS(2 + 7) == 2 && rep_ == 0) ? 1 : 0; asm volatile("" : "+s"(d_)); d_; })); SEAM(pb + 9); }
        if (IN(pb + 10)) for (int rep_ = 0; rep_ < REPS(2 + 10); ++rep_) {
            GEMM_SITE();
            const int* tg = (const int*)(F.ws + WS_CTL) + CW_TILE + l * 384;
            pg8::SchedMoe<true> S; S.tile_e = tg; S.ntile = __builtin_amdgcn_readfirstlane(tg[128]); S.nnl_shift = 2; S.G = F.G; S.c = F.bid; S.lda2 = (unsigned)DM; S.ldb2 = (unsigned)DM;
            S.rlist = (const int*)(F.ws + WS_RLIST); S.cnt = (const unsigned*)(F.ws + WS_CTL) + CW_CNT + l * 32;
            EpiMoe1 E{(unsigned char*)(F.ws + WS_H), 1.0f / 64};
            pg8::gemm_phase<EpiMoe1, pg8::SchedMoe<true>, DM, DM, DM, true>(F.lds, (const bf16_t*)(F.ws + WS_HB8), (const bf16_t*)(F.ws + WS_WGU + l * SZ_WGU), S, E, F.wave);
            if (l == 1 && F.G == 256 && F.bid >= BG_M1B_BLK0) bg_idle(F, CVT_Q_ALL - BG_M1B_TASKS, F.bid - BG_M1B_BLK0, BG_M1B);
            if (l == 0 && F.G == 256 && F.bid >= BG_M1_BLK0) bg_idle(F, CVT_Q_L1D + 128 * 8 * BG_PER_WAVE, F.bid - BG_M1_BLK0, BG_M1);
            SEAM(pb + 10); }
        if (IN(pb + 11)) for (int rep_ = 0; rep_ < REPS(2 + 11); ++rep_) {
            GEMM_SITE();
            const int* tg = (const int*)(F.ws + WS_CTL) + CW_TILE + l * 384;
            pg8::SchedMoe<false> S; S.rlist = nullptr; S.cnt = nullptr; S.tile_e = tg; S.ntile = __builtin_amdgcn_readfirstlane(tg[128]); S.nnl_shift = 3; S.G = F.G; S.c = F.bid; S.lda2 = (unsigned)MOE_H; S.ldb2 = (unsigned)MOE_H;
            EpiDown E{(bf16_t*)(F.ws + WS_Y2S)};
            pg8::gemm_phase<EpiDown, pg8::SchedMoe<false>, MOE_H, MOE_H, MOE_H, true>(F.lds, (const bf16_t*)(F.ws + WS_H), (const bf16_t*)(F.ws + WS_WD + l * SZ_WD), S, E, F.wave);
            SEAM(pb + 11); }
        if (IN(pb + 12)) for (int rep_ = 0; rep_ < REPS(2 + 12); ++rep_) { phase_combine(F, l, mrows); SEAM(pb + 12); }
#undef GEMM_SITE
}
#undef IN
#undef SEAM

constexpr int N_PHASES = 2 + 13 * NLAYER;
__global__ void __launch_bounds__(512, 2) fwd(Params prm) {
    extern __shared__ __attribute__((aligned(16))) unsigned char shm[];
    Frame F; F.ws = prm.ws; F.lds = (LAS unsigned char*)shm; F.ldsg = (char*)shm;
    F.tid = threadIdx.x; F.lane = F.tid & 63; F.wave = __builtin_amdgcn_readfirstlane(F.tid >> 6); F.G = gridDim.x; F.bid = blockIdx.x; F.gw = F.bid * 8 + F.wave; F.nwt = F.G * 8;
    if (F.tid < 4) ((LAS unsigned*)(F.lds + MISC_OFF))[F.tid] = 0u;
    if (F.tid == 0) { LAS unsigned long long* pt = (LAS unsigned long long*)(F.lds + PTAB_OFF);
#pragma unroll
        for (int i = 0; i < 32; ++i) pt[i] = (unsigned long long)prm.in[i];
        pt[32] = (unsigned long long)prm.out; }
    __syncthreads();
    const int lo = prm.ph_lo, hi = prm.ph_hi;
    XcdBarrier bar; bar.bar = (unsigned*)(F.ws + WS_CTL) + CW_BAR; bar.x = 0; bar.st = nullptr; bar.wave = F.wave;
    if (hi - lo > 1) bar = xcd_barrier_post((unsigned*)(F.ws + WS_CTL) + CW_BAR, (volatile LAS unsigned*)(F.lds + MISC_OFF), F.wave);
#define IN(k) (lo <= (k) && (k) < hi)
#define SEAM(k) do { if (IN((k) + 1)) xcd_barrier(bar); } while (0)
    if (IN(0)) for (int rep_ = 0; rep_ < REPS(0); ++rep_) { phase0(F); if (IN(1) || rep_ + 1 < REPS(0)) xcd_barrier(bar); }
    if (IN(1)) for (int rep_ = 0; rep_ < REPS(1); ++rep_) { phase_norm(F, 0, 0, TT); if (IN(2) || rep_ + 1 < REPS(1)) xcd_barrier(bar); }
    layer_body<0>(F, lo, hi, bar);
    layer_body<1>(F, lo, hi, bar);
#undef IN
#undef SEAM
}

extern "C" void kernel_launch(void* const* d_in, const int* in_sizes, int n_in, void* d_out, int out_size, void* d_ws, size_t ws_size, hipStream_t stream) {
    static int grid = 0;
    if (grid == 0) {
        if (n_in != 32 || out_size != TL * DM || ws_size < WS_END) { fprintf(stderr, "kernel_launch: unexpected shapes: n_in %d out %d ws %zu (need %zu)\n", n_in, out_size, ws_size, (size_t)WS_END); grid = -1; return; }
        int dev = 0, cus = 0, per_cu = 0;
        if (hipGetDevice(&dev) != hipSuccess || hipDeviceGetAttribute(&cus, hipDeviceAttributeMultiprocessorCount, dev) != hipSuccess) { grid = -1; return; }
        if (hipFuncSetAttribute((const void*)fwd, hipFuncAttributeMaxDynamicSharedMemorySize, LDS_BYTES) != hipSuccess) { fprintf(stderr, "kernel_launch: hipFuncSetAttribute failed\n"); grid = -1; return; }
        if (hipOccupancyMaxActiveBlocksPerMultiprocessor(&per_cu, (const void*)fwd, 512, LDS_BYTES) != hipSuccess || per_cu < 1) fprintf(stderr, "kernel_launch: occupancy query reports %d blocks per CU\n", per_cu);
        (void)hipGetLastError();
        grid = cus;
    }
    if (grid < 0) return;
    (void)hipMemsetAsync((char*)d_ws + WS_CTL, 0, CTL_BYTES, stream);
    Params p{};
    for (int i = 0; i < 32; ++i) p.in[i] = (const float*)d_in[i];
    p.out = (float*)d_out; p.ws = (unsigned char*)d_ws;
#if MK_ONE_LAUNCH
    p.ph_lo = 0; p.ph_hi = N_PHASES;
    hipLaunchKernelGGL(fwd, dim3(grid), dim3(512), LDS_BYTES, stream, p);
#else
    for (int ph = 0; ph < N_PHASES; ++ph) { p.ph_lo = ph; p.ph_hi = ph + 1; hipLaunchKernelGGL(fwd, dim3(grid), dim3(512), LDS_BYTES, stream, p); }
#endif
    const hipError_t le = hipPeekAtLastError();
    if (le != hipSuccess) fprintf(stderr, "kernel_launch: launch failed: %s\n", hipGetErrorName(le));
}
```
